# Optimizing an MI355X kernel written in HIP

```python
import jax, jax.numpy as jnp
from jax import lax
import numpy as np

D_MODEL = 4096
BATCH = 1
SEQ = 8192
DEPTH = 1

CONV_WIDTH = D_MODEL // 2
CONV_K = 3
POOL_WINDOWS = (2, 4, 8, 16)
N_POOL_GROUPS = len(POOL_WINDOWS)
POOL_WIDTH = D_MODEL // 2
POOL_GROUP = POOL_WIDTH // N_POOL_GROUPS
N_BRANCHES = 2
FFN_HIDDEN = ((8 * D_MODEL // 3 + 255) // 256) * 256
N_MOD = 6
IN_COLS = 3 * CONV_WIDTH + POOL_WIDTH + N_BRANCHES * D_MODEL
EPS = 1e-6

kernel_name = "hybrid_conv_pool_gated_block"


def rms_norm(x, gain):
    x32 = x.astype(jnp.float32)
    y = x32 * lax.rsqrt(jnp.mean(x32 * x32, axis=-1, keepdims=True) + EPS)
    return (y * gain.astype(jnp.float32)).astype(x.dtype)


def modulate(h, shift, scale):
    return h * (1.0 + scale[:, None, :]) + shift[:, None, :]


def causal_short_conv(u, w):
    s = u.shape[1]
    k_width = w.shape[0]
    up = jnp.pad(u, ((0, 0), (k_width - 1, 0), (0, 0)))
    y = w[0] * up[:, 0:s]
    for k in range(1, k_width):
        y = y + w[k] * up[:, k:k + s]
    return y


def causal_mean_minus_self(u, window):
    b, s, ch = u.shape
    u32 = u.astype(jnp.float32)
    cs = jnp.concatenate([jnp.zeros((b, 1, ch), jnp.float32), jnp.cumsum(u32, axis=1)], axis=1)
    hi = cs[:, 1:]
    lo = jnp.pad(cs[:, :s + 1 - window], ((0, 0), (window - 1, 0), (0, 0)))
    count = jnp.minimum(jnp.arange(1, s + 1), window).astype(jnp.float32)[None, :, None]
    return ((hi - lo) / count - u32).astype(u.dtype)


def hybrid_mixer(h, w_in, b_branch_gate, conv_w, w_conv_out, w_pool_group, pool_scale, w_pool_out, w_o):
    b, s, _ = h.shape
    proj = jnp.einsum('bsd,dn->bsn', h, w_in)
    c0 = CONV_WIDTH
    splits = [c0, 2 * c0, 3 * c0, 3 * c0 + POOL_WIDTH, 3 * c0 + POOL_WIDTH + D_MODEL]
    gate_b, gate_c, v, p, g_conv, g_pool = jnp.split(proj, splits, axis=-1)

    y_conv = jnp.einsum('bsc,cd->bsd', gate_b * causal_short_conv(gate_c * v, conv_w), w_conv_out)

    pg = p.reshape(b, s, N_POOL_GROUPS, POOL_GROUP)
    pooled = jnp.stack([causal_mean_minus_self(pg[:, :, g], POOL_WINDOWS[g]) for g in range(N_POOL_GROUPS)], axis=2)
    mixed = jnp.einsum('bsgc,gce->bsge', pooled, w_pool_group).reshape(b, s, POOL_WIDTH) * pool_scale
    y_pool = jnp.einsum('bsc,cd->bsd', mixed, w_pool_out)

    gb_conv, gb_pool = jnp.split(b_branch_gate, 2)
    merged = jax.nn.sigmoid(g_conv + gb_conv) * y_conv + jax.nn.sigmoid(g_pool + gb_pool) * y_pool
    return jnp.einsum('bsd,de->bse', merged, w_o)


def swiglu_ffn(h, w_gate_up, w_down):
    gu = jnp.einsum('bsd,df->bsf', h, w_gate_up)
    g, u = jnp.split(gu, 2, axis=-1)
    return jnp.einsum('bsf,fd->bsd', jax.nn.silu(g) * u, w_down)


def setup_inputs(seed: int = 0) -> dict:
    key = jax.random.key(seed)
    ks = jax.random.split(key, 20)
    f32 = jnp.float32
    nrm = lambda k, shape, scale: jax.random.normal(k, shape, f32) * scale
    return {
        "x": nrm(ks[0], (BATCH, SEQ, D_MODEL), 1.0),
        "c": nrm(ks[1], (BATCH, D_MODEL), 1.0),
        "w_ada": nrm(ks[2], (DEPTH, D_MODEL, N_MOD * D_MODEL), D_MODEL ** -0.5),
        "b_ada": nrm(ks[3], (DEPTH, N_MOD * D_MODEL), 0.02),
        "norm1_gain": 1.0 + nrm(ks[4], (DEPTH, D_MODEL), 0.05),
        "w_in": nrm(ks[5], (DEPTH, D_MODEL, IN_COLS), D_MODEL ** -0.5),
        "b_branch_gate": nrm(ks[6], (DEPTH, N_BRANCHES * D_MODEL), 0.02),
        "conv_w": nrm(ks[7], (DEPTH, CONV_K, CONV_WIDTH), CONV_K ** -0.5),
        "w_conv_out": nrm(ks[8], (DEPTH, CONV_WIDTH, D_MODEL), CONV_WIDTH ** -0.5),
        "w_pool_group": nrm(ks[9], (DEPTH, N_POOL_GROUPS, POOL_GROUP, POOL_GROUP), POOL_GROUP ** -0.5),
        "pool_scale": 1.0 + nrm(ks[10], (DEPTH, POOL_WIDTH), 0.05),
        "w_pool_out": nrm(ks[11], (DEPTH, POOL_WIDTH, D_MODEL), POOL_WIDTH ** -0.5),
        "w_o": nrm(ks[12], (DEPTH, D_MODEL, D_MODEL), D_MODEL ** -0.5),
        "norm2_gain": 1.0 + nrm(ks[13], (DEPTH, D_MODEL), 0.05),
        "w_gate_up": nrm(ks[14], (DEPTH, D_MODEL, 2 * FFN_HIDDEN), D_MODEL ** -0.5),
        "w_down": nrm(ks[15], (DEPTH, FFN_HIDDEN, D_MODEL), FFN_HIDDEN ** -0.5),
        "final_norm_gain": 1.0 + nrm(ks[16], (D_MODEL,), 0.05),
    }


def reference(x, c, w_ada, b_ada, norm1_gain, w_in, b_branch_gate, conv_w, w_conv_out, w_pool_group,
              pool_scale, w_pool_out, w_o, norm2_gain, w_gate_up, w_down, final_norm_gain):
    cs = jax.nn.silu(c)
    for l in range(DEPTH):
        mod = jnp.einsum('bd,dm->bm', cs, w_ada[l]) + b_ada[l]
        shift1, scale1, gate1, shift2, scale2, gate2 = jnp.split(mod, N_MOD, axis=-1)

        h = modulate(rms_norm(x, norm1_gain[l]), shift1, scale1)
        y = hybrid_mixer(h, w_in[l], b_branch_gate[l], conv_w[l], w_conv_out[l], w_pool_group[l],
                         pool_scale[l], w_pool_out[l], w_o[l])
        x = x + gate1[:, None, :] * y

        h = modulate(rms_norm(x, norm2_gain[l]), shift2, scale2)
        x = x + gate2[:, None, :] * swiglu_ffn(h, w_gate_up[l], w_down[l])
    return rms_norm(x, final_norm_gain)
```

```cpp
#include <hip/hip_runtime.h>
#include <cstdio>
#include <cstdint>

#ifndef MK_N_LAUNCHES
#define MK_N_LAUNCHES 1
#endif

namespace pg8 {
#define PG8_LAS __attribute__((address_space(3)))
typedef unsigned short bf16_t;
typedef short bf16x8 __attribute__((ext_vector_type(8)));
typedef float f32x4 __attribute__((ext_vector_type(4)));
typedef unsigned u32x4 __attribute__((ext_vector_type(4)));
constexpr int BM = 256, BK = 64, HALF = 128, HTB = HALF * BK * 2  , STAGE_BYTES = 8 * HTB, NXCD = 8, WGM = 8;

__host__ __device__ __forceinline__ int lds_byte(int r, int c) { const int st = (r >> 4) * 2 + (c >> 5), rr = r & 15, cc = c & 31, ob = rr * 64 + cc * 2; return st * 1024 + (ob ^ (((ob >> 9) & 1) << 5)); }
__host__ __device__ __forceinline__ void stage_rc(int b, int& R, int& C) { const int st = b / 1024, sb = b % 1024, swz = sb ^ (((sb >> 9) & 1) << 5); R = (st >> 1) * 16 + swz / 64; C = (st & 1) * 32 + (swz % 64) / 2; }
__host__ __device__ __forceinline__ int perm32(int rho) { const int n = rho >> 4, i = rho & 15; return 8 * (i >> 2) + 4 * n + (i & 3); }

struct Unit { int pm, pn, half; const char* a; const char* b; };
struct Gemm { int K, lda, ldb; };

template <int MODE> struct Order {
    int nM, nN, nwg, G, c; const char* A; const char* B; size_t a_tile, b_tile;
    __device__ __forceinline__ void init(int M, int N, int G_, int c_, const void* A_, const void* B_, int lda, int ldb) { nM = M / BM; nN = N / BM; nwg = nM * nN; G = G_; c = c_; A = (const char*)A_; B = (const char*)B_; a_tile = (size_t)BM * lda * 2; b_tile = (size_t)BM * ldb * 2; }
    __device__ __forceinline__ bool next(int i, Unit& u) const {
        const int ti = (MODE == 2) ? (i >> 1) : i;
        const long L = (long)ti * G + c; if (L >= nwg) return false;
        int wgid = (int)L; { const int q = nwg / NXCD, r = nwg % NXCD, xcd = wgid % NXCD, off = wgid / NXCD; wgid = (xcd < r ? xcd * (q + 1) : r * (q + 1) + (xcd - r) * q) + off; }
        const int nig = WGM * nN, gid = wgid / nig, fm = gid * WGM, gsz = (nM - fm) < WGM ? (nM - fm) : WGM;
        u.pm = fm + ((wgid % nig) % gsz); u.pn = (wgid % nig) / gsz; u.half = (MODE == 2) ? (i & 1) : 0;
        u.a = A + (size_t)u.pm * a_tile + (MODE == 1 ? (size_t)(u.pn >> 1) * 1024 : 0) + (MODE == 2 ? (size_t)u.half * 4096 : 0);
        u.b = B + (size_t)u.pn * b_tile + (MODE == 2 ? (size_t)u.half * 4096 : 0);
        return true;
    }
};

__device__ __forceinline__ unsigned cvt_pk_bf16(float lo, float hi) { unsigned r; asm volatile("v_cvt_pk_bf16_f32 %0, %1, %2" : "=v"(r) : "v"(lo), "v"(hi)); return r; }
__device__ __forceinline__ float bf_lo(unsigned w) { return __uint_as_float(w << 16); }
__device__ __forceinline__ float bf_hi(unsigned w) { return __uint_as_float(w & 0xffff0000u); }
__device__ __forceinline__ float exp_neg(float x) { return __builtin_amdgcn_exp2f(x * -1.44269504089f); }

struct EpiBf16 {
    static constexpr bool PERM = true;
    bf16_t* O; int ldc; const float* scale;
    __device__ __forceinline__ bool keep(const Unit&) const { return false; }
    __device__ __forceinline__ void operator()(f32x4 (&acc)[2][2][4][2], const Unit& u, int wr, int wc, int fr, int fq) const {
        const int row0 = u.pm * BM + wr * 64 + fr, col0 = u.pn * BM + wc * 32 + 8 * fq;
        f32x4 sv[2][2];
#pragma unroll
        for (int bj = 0; bj < 2; ++bj)
#pragma unroll
            for (int n = 0; n < 2; ++n) sv[bj][n] = scale ? *(const f32x4*)(scale + col0 + bj * HALF + 4 * n) : (f32x4){1.f, 1.f, 1.f, 1.f};
#pragma unroll
        for (int ai = 0; ai < 2; ++ai)
#pragma unroll
            for (int m = 0; m < 4; ++m) { bf16_t* rowp = O + (size_t)(row0 + ai * HALF + m * 16) * ldc + col0;
#pragma unroll
                for (int bj = 0; bj < 2; ++bj) { const f32x4 v0 = acc[ai][bj][m][0] * sv[bj][0], v1 = acc[ai][bj][m][1] * sv[bj][1];
                    u32x4 w; w.x = cvt_pk_bf16(v0[0], v0[1]); w.y = cvt_pk_bf16(v0[2], v0[3]); w.z = cvt_pk_bf16(v1[0], v1[1]); w.w = cvt_pk_bf16(v1[2], v1[3]);
                    *(u32x4*)(rowp + bj * HALF) = w; } }
    }
};
struct EpiMerge {
    static constexpr bool PERM = true;
    const bf16_t* proj; const float* gbias; bf16_t* O;
    __device__ __forceinline__ bool keep(const Unit& u) const { return u.half == 0; }
    __device__ __forceinline__ void operator()(f32x4 (&acc)[2][2][4][2], const Unit& u, int wr, int wc, int fr, int fq) const {
        const int row0 = u.pm * BM + wr * 64 + fr, col0 = u.pn * BM + wc * 32 + 8 * fq;
#pragma unroll
        for (int bj = 0; bj < 2; ++bj) {
            const int col = col0 + bj * HALF;
            const f32x4 bp0 = *(const f32x4*)(gbias + 4096 + col), bp1 = *(const f32x4*)(gbias + 4096 + col + 4);
            if (u.half == 0) {
                const f32x4 bc0 = *(const f32x4*)(gbias + col), bc1 = *(const f32x4*)(gbias + col + 4);
#pragma unroll
                for (int ai = 0; ai < 2; ++ai)
#pragma unroll
                    for (int m = 0; m < 4; ++m) { const bf16_t* rp = proj + (size_t)(row0 + ai * HALF + m * 16) * 16384 + col;
                        const u32x4 gc = *(const u32x4*)(rp + 8192), gp = *(const u32x4*)(rp + 12288);
#pragma unroll
                        for (int e = 0; e < 4; ++e) {
                            const float a0 = fmaxf(bf_lo(gc[e]) + (e < 2 ? bc0[2 * e] : bc1[2 * e - 4]), -60.f), a1 = fmaxf(bf_hi(gc[e]) + (e < 2 ? bc0[2 * e + 1] : bc1[2 * e - 3]), -60.f);
                            const float b0 = fmaxf(bf_lo(gp[e]) + (e < 2 ? bp0[2 * e] : bp1[2 * e - 4]), -60.f), b1 = fmaxf(bf_hi(gp[e]) + (e < 2 ? bp0[2 * e + 1] : bp1[2 * e - 3]), -60.f);
                            const float r0 = (1.f + exp_neg(b0)) * __builtin_amdgcn_rcpf(1.f + exp_neg(a0)), r1 = (1.f + exp_neg(b1)) * __builtin_amdgcn_rcpf(1.f + exp_neg(a1));
                            if (e < 2) { acc[ai][bj][m][0][2 * e] *= r0; acc[ai][bj][m][0][2 * e + 1] *= r1; } else { acc[ai][bj][m][1][2 * e - 4] *= r0; acc[ai][bj][m][1][2 * e - 3] *= r1; } } }
            } else {
#pragma unroll
                for (int ai = 0; ai < 2; ++ai)
#pragma unroll
                    for (int m = 0; m < 4; ++m) { const size_t row = (size_t)(row0 + ai * HALF + m * 16);
                        const u32x4 gp = *(const u32x4*)(proj + row * 16384 + 12288 + col); float s[8];
#pragma unroll
                        for (int e = 0; e < 4; ++e) {
                            const float b0 = fmaxf(bf_lo(gp[e]) + (e < 2 ? bp0[2 * e] : bp1[2 * e - 4]), -60.f), b1 = fmaxf(bf_hi(gp[e]) + (e < 2 ? bp0[2 * e + 1] : bp1[2 * e - 3]), -60.f);
                            s[2 * e] = __builtin_amdgcn_rcpf(1.f + exp_neg(b0)); s[2 * e + 1] = __builtin_amdgcn_rcpf(1.f + exp_neg(b1)); }
                        const f32x4 v0 = acc[ai][bj][m][0], v1 = acc[ai][bj][m][1];
                        u32x4 w; w.x = cvt_pk_bf16(v0[0] * s[0], v0[1] * s[1]); w.y = cvt_pk_bf16(v0[2] * s[2], v0[3] * s[3]); w.z = cvt_pk_bf16(v1[0] * s[4], v1[1] * s[5]); w.w = cvt_pk_bf16(v1[2] * s[6], v1[3] * s[7]);
                        *(u32x4*)(O + row * 4096 + col) = w; }
            }
        }
    }
};
struct EpiResid {
    static constexpr bool PERM = false;
    const float* base; const float* gate; float* out; int ldc;
    __device__ __forceinline__ bool keep(const Unit&) const { return false; }
    __device__ __forceinline__ void operator()(f32x4 (&acc)[2][2][4][2], const Unit& u, int wr, int wc, int fr, int fq) const {
        const int row0 = u.pm * BM + wr * 64 + fr, col0 = u.pn * BM + wc * 32 + 4 * fq;
        f32x4 gv[2][2];
#pragma unroll
        for (int bj = 0; bj < 2; ++bj)
#pragma unroll
            for (int n = 0; n < 2; ++n) gv[bj][n] = *(const f32x4*)(gate + col0 + bj * HALF + n * 16);
#pragma unroll
        for (int ai = 0; ai < 2; ++ai)
#pragma unroll
            for (int m = 0; m < 4; ++m) { const size_t off = (size_t)(row0 + ai * HALF + m * 16) * ldc + col0;
#pragma unroll
                for (int bj = 0; bj < 2; ++bj)
#pragma unroll
                    for (int n = 0; n < 2; ++n) { const f32x4 bs = *(const f32x4*)(base + off + bj * HALF + n * 16); *(f32x4*)(out + off + bj * HALF + n * 16) = bs + gv[bj][n] * acc[ai][bj][m][n]; }
                if (m & 1) asm volatile("" ::: "memory"); }
    }
};
struct EpiSwiglu {
    static constexpr bool PERM = true;
    bf16_t* O; int ldc;
    __device__ __forceinline__ bool keep(const Unit&) const { return false; }
    __device__ __forceinline__ void operator()(f32x4 (&acc)[2][2][4][2], const Unit& u, int wr, int wc, int fr, int fq) const {
        const int row0 = u.pm * BM + wr * 64 + fr, col0 = u.pn * HALF + wc * 32 + 8 * fq;
#pragma unroll
        for (int ai = 0; ai < 2; ++ai)
#pragma unroll
            for (int m = 0; m < 4; ++m) { float o[8];
#pragma unroll
                for (int n = 0; n < 2; ++n)
#pragma unroll
                    for (int e = 0; e < 4; ++e) { const float g = acc[ai][0][m][n][e], up = acc[ai][1][m][n][e]; o[4 * n + e] = g * __builtin_amdgcn_rcpf(1.f + exp_neg(g)) * up; }
                u32x4 w; w.x = cvt_pk_bf16(o[0], o[1]); w.y = cvt_pk_bf16(o[2], o[3]); w.z = cvt_pk_bf16(o[4], o[5]); w.w = cvt_pk_bf16(o[6], o[7]);
                *(u32x4*)(O + (size_t)(row0 + ai * HALF + m * 16) * ldc + col0) = w; }
    }
};

template <class Epi, class Sched, bool ALIGN_EPI = true, bool SP2 = true>
__device__ __forceinline__ void gemm_phase(PG8_LAS unsigned char* lds, const Gemm g, const Sched& S, const Epi& E) {
    const int tid = threadIdx.x, wid = __builtin_amdgcn_readfirstlane(tid >> 6), lane = tid & 63, wr = wid >> 2, wc = wid & 3, fr = lane & 15, fq = lane >> 4;
    const int K = g.K, nt = K / BK;
    unsigned voffA[2], voffB[2];
#pragma unroll
    for (int i = 0; i < 2; ++i) { int R, C; stage_rc(tid * 16 + i * 8192, R, C); const int Rb = Epi::PERM ? ((R & ~31) + perm32(R & 31)) : R;
        voffA[i] = (unsigned)(R * g.lda + C) * 2u; voffB[i] = (unsigned)(Rb * g.ldb + C) * 2u; }
    const size_t kstep = (size_t)(BK * 2);
    const size_t hstepA = (size_t)HALF * g.lda * 2, hstepB = (size_t)HALF * g.ldb * 2;
    const unsigned ldsw = (unsigned)wid * 1024u;
    const int aoff = lds_byte(wr * 64 + fr, fq * 8), boff = lds_byte(wc * 32 + fr, fq * 8);
#define PG8_SA(b, h) (((b) * 2 + (h)) * HTB)
#define PG8_SB(b, h) ((4 + (b) * 2 + (h)) * HTB)
#define PG8_STAGE(bufoff, gbase, voff) do { _Pragma("unroll") for (int _i = 0; _i < 2; ++_i) \
        __builtin_amdgcn_global_load_lds((const unsigned*)((const char*)(gbase) + (voff)[_i]), (PG8_LAS unsigned*)(lds + (bufoff) + ldsw + _i * 8192), 16, 0, 0); } while (0)
#define PG8_LDA(dst, b, h) do { _Pragma("unroll") for (int m = 0; m < 4; ++m) _Pragma("unroll") for (int k = 0; k < 2; ++k) dst[m][k] = *(const PG8_LAS bf16x8*)(lds + PG8_SA(b, h) + aoff + m * 2048 + k * 1024); } while (0)
#define PG8_LDB(dst, b, h) do { _Pragma("unroll") for (int n = 0; n < 2; ++n) _Pragma("unroll") for (int k = 0; k < 2; ++k) dst[n][k] = *(const PG8_LAS bf16x8*)(lds + PG8_SB(b, h) + boff + n * 2048 + k * 1024); } while (0)
#define PG8_MMA(ai, bj, At, Bt) do { __builtin_amdgcn_s_setprio(1); _Pragma("unroll") for (int m = 0; m < 4; ++m) _Pragma("unroll") for (int n = 0; n < 2; ++n) _Pragma("unroll") for (int k = 0; k < 2; ++k) \
        acc[ai][bj][m][n] = __builtin_amdgcn_mfma_f32_16x16x32_bf16(Bt[n][k], At[m][k], acc[ai][bj][m][n], 0, 0, 0); __builtin_amdgcn_s_setprio(0); } while (0)
#define PG8_WAIT_V(n) asm volatile("s_waitcnt vmcnt(" #n ")" ::: "memory")
#define PG8_WAIT_L(n) asm volatile("s_waitcnt lgkmcnt(" #n ")" ::: "memory")
#define PG8_BAR __builtin_amdgcn_s_barrier()
#define PG8_SCHED __builtin_amdgcn_sched_barrier(0)
    Unit cur, nxt; int ui = 0;
    if (!S.next(0, cur)) return;
    f32x4 acc[2][2][4][2];
#pragma unroll
    for (int a = 0; a < 2; ++a)
#pragma unroll
        for (int b = 0; b < 2; ++b)
#pragma unroll
            for (int m = 0; m < 4; ++m)
#pragma unroll
                for (int n = 0; n < 2; ++n) acc[a][b][m][n] = (f32x4){0.f, 0.f, 0.f, 0.f};
    bf16x8 At[4][2], B0[2][2], B1[2][2];
    const char* cA = cur.a; const char* cB = cur.b;
    if constexpr (SP2) {
        PG8_STAGE(PG8_SB(0, 0), cB, voffB); PG8_STAGE(PG8_SB(0, 1), cB + hstepB, voffB); PG8_STAGE(PG8_SA(0, 0), cA, voffA); PG8_STAGE(PG8_SA(0, 1), cA + hstepA, voffA);
        if (wr == 1) PG8_BAR;
        PG8_WAIT_V(2); PG8_BAR;
        PG8_STAGE(PG8_SB(1, 0), cB + kstep, voffB); PG8_STAGE(PG8_SA(1, 0), cA + kstep, voffA); PG8_STAGE(PG8_SB(1, 1), cB + hstepB + kstep, voffB);
        PG8_WAIT_V(6); PG8_BAR;
    } else {
        PG8_STAGE(PG8_SB(0, 0), cB, voffB); PG8_STAGE(PG8_SA(0, 0), cA, voffA); PG8_STAGE(PG8_SB(0, 1), cB + hstepB, voffB); PG8_STAGE(PG8_SA(0, 1), cA + hstepA, voffA);
        if (wr == 1) PG8_BAR;
        PG8_WAIT_V(4); PG8_BAR;
        PG8_STAGE(PG8_SB(1, 0), cB + kstep, voffB); PG8_STAGE(PG8_SA(1, 0), cA + kstep, voffA); PG8_STAGE(PG8_SB(1, 1), cB + hstepB + kstep, voffB);
        PG8_WAIT_V(6); PG8_BAR;
    }
    for (;;) {
        const bool has_next = S.next(ui + 1, nxt);
        const char* nA = has_next ? nxt.a : cA; const char* nB = has_next ? nxt.b : cB;
        for (int t = 0; t < nt; t += 2) {
            const bool last = (t == nt - 2);
            const char* a1 = cA + (size_t)(t + 1) * kstep;
            const char* a2 = last ? nA : cA + (size_t)(t + 2) * kstep; const char* b2 = last ? nB : cB + (size_t)(t + 2) * kstep;
            const char* a3 = a2 + kstep; const char* b3 = b2 + kstep;
            if constexpr (SP2) {
            PG8_LDB(B0, 0, 0); PG8_LDB(B1, 0, 1); PG8_SCHED; PG8_LDA(At, 0, 0); PG8_STAGE(PG8_SA(1, 1), a1 + hstepA, voffA);
            PG8_WAIT_V(8); PG8_WAIT_L(0); PG8_BAR; PG8_MMA(0, 0, At, B0); PG8_MMA(0, 1, At, B1); PG8_BAR; PG8_SCHED;
            PG8_LDA(At, 0, 1); PG8_STAGE(PG8_SB(0, 0), b2, voffB); PG8_STAGE(PG8_SB(0, 1), b2 + hstepB, voffB); PG8_STAGE(PG8_SA(0, 0), a2, voffA);
            PG8_WAIT_V(8); PG8_WAIT_L(0); PG8_BAR; PG8_MMA(1, 0, At, B0); PG8_MMA(1, 1, At, B1); PG8_BAR; PG8_SCHED;
            PG8_LDB(B0, 1, 0); PG8_LDB(B1, 1, 1); PG8_SCHED; PG8_LDA(At, 1, 0); PG8_STAGE(PG8_SA(0, 1), a2 + hstepA, voffA);
            PG8_WAIT_V(8); PG8_WAIT_L(0); PG8_BAR; PG8_MMA(0, 0, At, B0); PG8_MMA(0, 1, At, B1); PG8_BAR; PG8_SCHED;
            PG8_LDA(At, 1, 1); PG8_STAGE(PG8_SB(1, 0), b3, voffB); PG8_STAGE(PG8_SB(1, 1), b3 + hstepB, voffB); PG8_STAGE(PG8_SA(1, 0), a3, voffA);
            PG8_WAIT_V(8); PG8_WAIT_L(0); PG8_BAR; PG8_MMA(1, 0, At, B0); PG8_MMA(1, 1, At, B1); PG8_BAR; PG8_SCHED;
            } else {
            PG8_LDB(B0, 0, 0); PG8_SCHED; PG8_LDA(At, 0, 0); PG8_STAGE(PG8_SA(1, 1), a1 + hstepA, voffA);
            PG8_WAIT_L(8); PG8_BAR; PG8_WAIT_L(0); PG8_MMA(0, 0, At, B0); PG8_BAR; PG8_SCHED;
            PG8_LDB(B1, 0, 1); PG8_STAGE(PG8_SB(0, 0), b2, voffB);
            PG8_BAR; PG8_WAIT_L(0); PG8_MMA(0, 1, At, B1); PG8_BAR;
            PG8_LDA(At, 0, 1); PG8_STAGE(PG8_SA(0, 0), a2, voffA);
            PG8_BAR; PG8_WAIT_L(0); PG8_MMA(1, 0, At, B0); PG8_BAR; PG8_SCHED;
            PG8_STAGE(PG8_SB(0, 1), b2 + hstepB, voffB);
            PG8_WAIT_V(6); PG8_BAR; PG8_MMA(1, 1, At, B1); PG8_BAR;
            PG8_LDB(B0, 1, 0); PG8_SCHED; PG8_LDA(At, 1, 0); PG8_STAGE(PG8_SA(0, 1), a2 + hstepA, voffA);
            PG8_WAIT_L(8); PG8_BAR; PG8_WAIT_L(0); PG8_MMA(0, 0, At, B0); PG8_BAR; PG8_SCHED;
            PG8_LDB(B1, 1, 1); PG8_STAGE(PG8_SB(1, 0), b3, voffB);
            PG8_BAR; PG8_WAIT_L(0); PG8_MMA(0, 1, At, B1); PG8_BAR;
            PG8_LDA(At, 1, 1); PG8_STAGE(PG8_SA(1, 0), a3, voffA);
            PG8_BAR; PG8_WAIT_L(0); PG8_MMA(1, 0, At, B0); PG8_BAR; PG8_SCHED;
            PG8_STAGE(PG8_SB(1, 1), b3 + hstepB, voffB);
            PG8_WAIT_V(6); PG8_BAR; PG8_MMA(1, 1, At, B1); PG8_BAR;
            }
        }
        if constexpr (ALIGN_EPI) { if (wr == 0) PG8_BAR; }
        E(acc, cur, wr, wc, fr, fq);
        if (!has_next) break;
        if (!E.keep(cur)) {
#pragma unroll
        for (int a = 0; a < 2; ++a)
#pragma unroll
            for (int b = 0; b < 2; ++b)
#pragma unroll
                for (int m = 0; m < 4; ++m)
#pragma unroll
                    for (int n = 0; n < 2; ++n) acc[a][b][m][n] = (f32x4){0.f, 0.f, 0.f, 0.f};
        }
        cur = nxt; cA = nA; cB = nB; ++ui;
        if constexpr (ALIGN_EPI) { if (wr == 1) PG8_BAR; }
    }
    PG8_WAIT_V(0);
    if constexpr (!ALIGN_EPI) { if (wr == 0) PG8_BAR; }
    PG8_BAR;
#undef PG8_SA
#undef PG8_SB
#undef PG8_STAGE
#undef PG8_LDA
#undef PG8_LDB
#undef PG8_MMA
#undef PG8_WAIT_V
#undef PG8_WAIT_L
#undef PG8_BAR
#undef PG8_SCHED
}
}

constexpr int NWAVES = 8;
constexpr int N_LAUNCHES = MK_N_LAUNCHES;
constexpr int PER_PHASE = 11;

constexpr int S = 8192, D = 4096, CW = 2048, PW = 2048, PGRP = 512, FF = 11008, INC = 16384, NMODV = 6 * D;
constexpr float EPS = 1e-6f;
constexpr int KSPLIT = 8;

constexpr size_t MiB = 1u << 20;
constexpr size_t WS_CTL = 0, CTL_ZERO_BYTES = 64 * 1024;
constexpr size_t WS_MODP = 1 * MiB;
constexpr size_t WS_MODF = WS_MODP + (size_t)KSPLIT * NMODV * 4;
constexpr size_t WS_WIN = 2 * MiB;
constexpr size_t WS_WCP = 130 * MiB;
constexpr size_t WS_WPG = 162 * MiB;
constexpr size_t WS_WO = 164 * MiB;
constexpr size_t WS_WGU = 196 * MiB;
constexpr size_t WS_WD = 368 * MiB;
constexpr size_t WS_H = 454 * MiB;
constexpr size_t WS_PROJ = 518 * MiB;
constexpr size_t WS_AM = 774 * MiB;
constexpr size_t WS_POOLED = 838 * MiB;
constexpr size_t WS_MERGED = 870 * MiB;
constexpr size_t WS_X1 = 934 * MiB;
constexpr size_t WS_H2 = 1062 * MiB;
constexpr size_t WS_ACT = 1126 * MiB;
constexpr size_t WS_END = 1298 * MiB;
static_assert(WS_MODF + NMODV * 4 <= WS_WIN && WS_ACT + (size_t)S * FF * 2 <= WS_END, "d_ws map");
constexpr int CW_BAR = 1024;
constexpr int RING_OFF = 0, RING_BYTES = 131072;
constexpr int LDSCTL_OFF = RING_BYTES + 8192, MISC_OFF = LDSCTL_OFF;
constexpr int LDS_BYTES = 147456;

#define GAS __attribute__((address_space(1)))
#define LAS __attribute__((address_space(3)))
typedef unsigned short bf16;
typedef unsigned v4u __attribute__((ext_vector_type(4)));
typedef float f32x4 __attribute__((ext_vector_type(4)));
typedef GAS unsigned gu32;
#define RLX_AGENT __ATOMIC_RELAXED, __HIP_MEMORY_SCOPE_AGENT
#define LDS_WAIT() asm volatile("s_waitcnt lgkmcnt(0)" ::: "memory")
__device__ __forceinline__ unsigned pk2(float lo, float hi) { return pg8::cvt_pk_bf16(lo, hi); }
__device__ __forceinline__ void unpack8(const v4u w, float (&f)[8]) {
#pragma unroll
    for (int e = 0; e < 4; ++e) { f[2 * e] = pg8::bf_lo(w[e]); f[2 * e + 1] = pg8::bf_hi(w[e]); } }
__device__ __forceinline__ v4u pack8(const float (&f)[8]) { v4u w; w.x = pk2(f[0], f[1]); w.y = pk2(f[2], f[3]); w.z = pk2(f[4], f[5]); w.w = pk2(f[6], f[7]); return w; }

#define XB_TMO      128
#define XB_XCNT(j)  (256  + 64 * (j))
#define XB_XSUB(j)  (1280 + 64 * (j))
#define XB_XGEN(j)  (2304 + 64 * (j))
#define XB_TOP      3328
#define XB_TOPGEN   3392
#define XCD_BAR_WORDS 3456
#define XB_SPIN_CAP (1u << 18)
static_assert((CW_BAR + XCD_BAR_WORDS) * 4 <= (int)CTL_ZERO_BYTES, "barrier words inside the memset region");

__device__ __forceinline__ unsigned xb_ld(unsigned* p)              { return __hip_atomic_load(p, __ATOMIC_RELAXED, __HIP_MEMORY_SCOPE_AGENT); }
__device__ __forceinline__ unsigned xb_add(unsigned* p, unsigned v) { return __hip_atomic_fetch_add(p, v, __ATOMIC_RELAXED, __HIP_MEMORY_SCOPE_AGENT); }
__device__ __forceinline__ unsigned xb_xcc_id() { return (unsigned)__builtin_amdgcn_s_getreg((3 << 11) | 20) & 0xFu; }
#define XB_SPIN(cond, bar) do { unsigned _sp = 0; while (cond) { __builtin_amdgcn_s_sleep(1); \
    if ((++_sp & 255u) == 0u) { if (xb_ld(&(bar)[XB_TMO])) break; if (_sp > XB_SPIN_CAP) { atomicAdd(&(bar)[XB_TMO], 1u); break; } } } } while (0)

struct XcdBarrier {
    unsigned* bar; unsigned x;
    volatile LAS unsigned* st;
};
__device__ __forceinline__ XcdBarrier xcd_barrier_post(unsigned* bar, volatile LAS unsigned* st) {
    XcdBarrier b; b.bar = bar; b.x = xb_xcc_id(); b.st = st;
    if (threadIdx.x == 0) (void)xb_add(&bar[XB_XCNT(b.x)], 1u);
    return b;
}
__device__ __forceinline__ void xcd_barrier_complete(unsigned* bar, unsigned x, unsigned& nloc, unsigned& nx) {
    const unsigned G = gridDim.x * gridDim.y * gridDim.z;
    unsigned sum, cnt, mine, sp = 0u;
    for (;;) {
        sum = 0u; cnt = 0u; mine = 0u;
#pragma unroll
        for (unsigned j = 0; j < 16; ++j) { const unsigned c = xb_ld(&bar[XB_XCNT(j)]); sum += c; cnt += (c > 0u) ? 1u : 0u; mine = (j == x) ? c : mine; }
        if (sum == G) break;
        __builtin_amdgcn_s_sleep(1);
        if ((++sp & 255u) == 0u) { if (xb_ld(&bar[XB_TMO])) break; if (sp > XB_SPIN_CAP) { atomicAdd(&bar[XB_TMO], 1u); break; } }
    }
    nloc = mine > 0u ? mine : 1u; nx = cnt > 0u ? cnt : 1u;
}
__device__ __forceinline__ void xcd_barrier(const XcdBarrier& b) {
    asm volatile("s_waitcnt vmcnt(0)" ::: "memory");
    __syncthreads();
    if (threadIdx.x == 0) {
        unsigned* bar = b.bar;
        __builtin_amdgcn_s_waitcnt(0);
        unsigned nloc = b.st[0], nx = b.st[1];
        if (nloc == 0u) { xcd_barrier_complete(bar, b.x, nloc, nx); b.st[0] = nloc; b.st[1] = nx; }
        const unsigned old = xb_add(&bar[XB_XSUB(b.x)], 1u);
        const unsigned gen = old / nloc;
        if (old + 1u == (gen + 1u) * nloc) {
            __builtin_amdgcn_fence(__ATOMIC_RELEASE, "agent");
            asm volatile("s_waitcnt vmcnt(0)" ::: "memory");
            const unsigned og = xb_add(&bar[XB_TOP], 1u);
            const unsigned tg = og / nx;
            if (og + 1u == (tg + 1u) * nx) xb_add(&bar[XB_TOPGEN], 1u);
            else XB_SPIN(xb_ld(&bar[XB_TOPGEN]) == tg, bar);
            __builtin_amdgcn_fence(__ATOMIC_ACQUIRE, "agent");
            xb_add(&bar[XB_XGEN(b.x)], 1u);
            asm volatile("s_waitcnt vmcnt(0)" ::: "memory");
        } else {
            XB_SPIN(xb_ld(&bar[XB_XGEN(b.x)]) == gen, bar);
            __builtin_amdgcn_fence(__ATOMIC_ACQUIRE, "agent");
            asm volatile("s_waitcnt vmcnt(0)" ::: "memory");
        }
    }
    __syncthreads();
}

struct Frame {
    LAS unsigned char* lds;
    volatile LAS unsigned* MISC;
    gu32* ctl;
    int tid, lane, wave;
    int vcu, G;
    const float *x, *cvec, *w_ada, *b_ada, *g1, *w_in, *gbias, *conv_w, *w_conv_out, *w_pool_group, *pool_scale, *w_pool_out, *w_o, *g2, *w_gate_up, *w_down, *gf;
    float* out;
    float *MODP, *MODF, *X1;
    bf16 *Win_t, *Wcp_t, *Wpg_t, *Wo_t, *Wgu_t, *Wd_t, *H, *PROJ, *AM, *POOLED, *MERGED, *H2, *ACT;
};

__device__ __forceinline__ float wave_sum(float v) {
#pragma unroll
    for (int o = 1; o < 64; o <<= 1) v += __shfl_xor(v, o);
    return v;
}

__device__ __forceinline__ void tr_item(const float* W, int N, int k0, int n0, bf16* dst, size_t dpitch, LAS float* scr, int lane) {
    const GAS f32x4* src = (const GAS f32x4*)(W + (size_t)(k0 + (lane >> 4)) * N + n0 + 4 * (lane & 15));
    f32x4 v[16];
#pragma unroll
    for (int i = 0; i < 16; ++i) v[i] = src[(size_t)i * N];
#pragma unroll
    for (int i = 0; i < 16; ++i) { LAS float* p = scr + (4 * i + (lane >> 4)) * 65 + 4 * (lane & 15); p[0] = v[i].x; p[1] = v[i].y; p[2] = v[i].z; p[3] = v[i].w; }
    LDS_WAIT(); asm volatile("" ::: "memory");
    const int c = lane >> 3;
#pragma unroll
    for (int j = 0; j < 8; ++j) { const int n = (lane & 7) + 8 * j; const LAS float* s = scr + (8 * c) * 65 + n;
        v4u o; o.x = pk2(s[0 * 65], s[1 * 65]); o.y = pk2(s[2 * 65], s[3 * 65]); o.z = pk2(s[4 * 65], s[5 * 65]); o.w = pk2(s[6 * 65], s[7 * 65]);
        *(GAS v4u*)(dst + (size_t)n * dpitch + 8 * c) = o; }
    LDS_WAIT(); asm volatile("" ::: "memory");
}

__device__ __forceinline__ void p0_prologue(Frame& F) {
    {
        LAS float* cs = (LAS float*)(F.lds);
        LAS float* red = (LAS float*)(F.lds + 16384);
        for (int i = F.tid; i < D; i += NWAVES * 64) { const float c = F.cvec[i]; cs[i] = c / (1.f + __expf(-c)); }
        __syncthreads();
        for (int it = blockIdx.x; it < 96 * KSPLIT; it += F.G) {
            const int cch = it % 96, kr = it / 96, rbase = kr * 512 + F.wave * 64;
            const float* wp = F.w_ada + (size_t)rbase * NMODV + cch * 256 + F.lane * 4;
            f32x4 a = (f32x4){0.f, 0.f, 0.f, 0.f};
#pragma unroll 1
            for (int r0 = 0; r0 < 64; r0 += 16) { f32x4 v[16];
#pragma unroll
                for (int q = 0; q < 16; ++q) v[q] = *(const GAS f32x4*)(wp + (size_t)(r0 + q) * NMODV);
#pragma unroll
                for (int q = 0; q < 16; ++q) a += v[q] * cs[rbase + r0 + q]; }
            *(LAS f32x4*)(red + F.wave * 256 + F.lane * 4) = a;
            __syncthreads();
            if (F.tid < 256) { float s = 0.f;
#pragma unroll
                for (int w = 0; w < 8; ++w) s += red[w * 256 + F.tid];
                F.MODP[(size_t)kr * NMODV + cch * 256 + F.tid] = s; }
            __syncthreads();
        }
    }
    LAS float* scr = (LAS float*)(F.lds + RING_OFF + F.wave * 16640);
    const int gw = F.vcu * NWAVES + F.wave, NGW = F.G * NWAVES;
    constexpr int I_IN = (D / 64) * (INC / 64), I_CV = (CW / 64) * (D / 64), I_PG = 4 * (PGRP / 64) * (PGRP / 64), I_O = (D / 64) * (D / 64), I_GU = (D / 64) * (2 * FF / 64), I_DN = (FF / 64) * (D / 64);
    constexpr int NITEMS = I_IN + 2 * I_CV + I_PG + I_O + I_GU + I_DN;
    for (int it = gw; it < NITEMS; it += NGW) {
        int r = it;
        if (r < I_IN) { const int nb = INC / 64, kb = r / nb, n0 = (r % nb) * 64; tr_item(F.w_in, INC, kb * 64, n0, F.Win_t + (size_t)n0 * D + kb * 64, D, scr, F.lane); continue; } r -= I_IN;
        if (r < I_CV) { const int nb = D / 64, kb = r / nb, n0 = (r % nb) * 64; tr_item(F.w_conv_out, D, kb * 64, n0, F.Wcp_t + (size_t)n0 * D + kb * 64, D, scr, F.lane); continue; } r -= I_CV;
        if (r < I_CV) { const int nb = D / 64, kb = r / nb, n0 = (r % nb) * 64; tr_item(F.w_pool_out, D, kb * 64, n0, F.Wcp_t + (size_t)n0 * D + CW + kb * 64, D, scr, F.lane); continue; } r -= I_CV;
        if (r < I_PG) { const int g = r / 64, q = r % 64, kb = q / 8, n0 = (q % 8) * 64; tr_item(F.w_pool_group + (size_t)g * PGRP * PGRP, PGRP, kb * 64, n0, F.Wpg_t + (size_t)(g * PGRP + n0) * PGRP + kb * 64, PGRP, scr, F.lane); continue; } r -= I_PG;
        if (r < I_O) { const int nb = D / 64, kb = r / nb, n0 = (r % nb) * 64; tr_item(F.w_o, D, kb * 64, n0, F.Wo_t + (size_t)n0 * D + kb * 64, D, scr, F.lane); continue; } r -= I_O;
        if (r < I_GU) { const int nb = 2 * FF / 64, kb = r / nb, n0 = (r % nb) * 64; const int isup = n0 >= FF, nn = isup ? n0 - FF : n0, drow = (nn >> 7) * 256 + isup * 128 + (nn & 127);
            tr_item(F.w_gate_up, 2 * FF, kb * 64, n0, F.Wgu_t + (size_t)drow * D + kb * 64, D, scr, F.lane); continue; } r -= I_GU;
        { const int nb = D / 64, kb = r / nb, n0 = (r % nb) * 64; tr_item(F.w_down, D, kb * 64, n0, F.Wd_t + (size_t)n0 * FF + kb * 64, FF, scr, F.lane); }
    }
}

__device__ __forceinline__ void norm_rows_bf16(Frame& F, const float* src, bf16* dst, const LAS float* Amul, const LAS float* Badd) {
    const int gw = F.vcu * NWAVES + F.wave, NGW = F.G * NWAVES;
    for (int r = gw; r < S; r += NGW) {
        const GAS f32x4* xr = (const GAS f32x4*)(src + (size_t)r * D) + F.lane;
        f32x4 v[16]; float s = 0.f;
#pragma unroll
        for (int j = 0; j < 16; ++j) { v[j] = xr[64 * j]; s += (v[j].x * v[j].x + v[j].y * v[j].y) + (v[j].z * v[j].z + v[j].w * v[j].w); }
        const float rstd = 1.f / sqrtf(wave_sum(s) * (1.f / D) + EPS);
        GAS unsigned long long* o8 = (GAS unsigned long long*)(dst + (size_t)r * D) + F.lane;
#pragma unroll
        for (int j = 0; j < 16; ++j) { const f32x4 a = *(const LAS f32x4*)(Amul + 4 * F.lane + 256 * j), b = *(const LAS f32x4*)(Badd + 4 * F.lane + 256 * j);
            const f32x4 o = v[j] * rstd * a + b;
            o8[64 * j] = (unsigned long long)pk2(o.x, o.y) | ((unsigned long long)pk2(o.z, o.w) << 32); }
    }
}

__device__ __forceinline__ void p1_norm1(Frame& F) {
    LAS float* Amul = (LAS float*)(F.lds); LAS float* Badd = (LAS float*)(F.lds + 16384);
    for (int d = F.tid; d < D; d += NWAVES * 64) { float sh = F.b_ada[d], sc = F.b_ada[D + d];
#pragma unroll
        for (int p = 0; p < KSPLIT; ++p) { sh += F.MODP[(size_t)p * NMODV + d]; sc += F.MODP[(size_t)p * NMODV + D + d]; }
        Amul[d] = F.g1[d] * (1.f + sc); Badd[d] = sh; }
    { const int gt = blockIdx.x * (NWAVES * 64) + F.tid;
      for (int j = gt; j < NMODV; j += F.G * NWAVES * 64) { float s = F.b_ada[j];
#pragma unroll
          for (int p = 0; p < KSPLIT; ++p) s += F.MODP[(size_t)p * NMODV + j];
          F.MODF[j] = s; } }
    __syncthreads();
    norm_rows_bf16(F, F.x, F.H, Amul, Badd);
}
__device__ __forceinline__ void p7_norm2(Frame& F) {
    LAS float* Amul = (LAS float*)(F.lds); LAS float* Badd = (LAS float*)(F.lds + 16384);
    for (int d = F.tid; d < D; d += NWAVES * 64) { Amul[d] = F.g2[d] * (1.f + F.MODF[4 * D + d]); Badd[d] = F.MODF[3 * D + d]; }
    __syncthreads();
    norm_rows_bf16(F, F.X1, F.H2, Amul, Badd);
}
__device__ __forceinline__ void p10_final_norm(Frame& F) {
    const int gw = F.vcu * NWAVES + F.wave, NGW = F.G * NWAVES;
    for (int r = gw; r < S; r += NGW) {
        GAS f32x4* xr = (GAS f32x4*)(F.out + (size_t)r * D) + F.lane;
        f32x4 v[16]; float s = 0.f;
#pragma unroll
        for (int j = 0; j < 16; ++j) { v[j] = xr[64 * j]; s += (v[j].x * v[j].x + v[j].y * v[j].y) + (v[j].z * v[j].z + v[j].w * v[j].w); }
        const float rstd = 1.f / sqrtf(wave_sum(s) * (1.f / D) + EPS);
#pragma unroll
        for (int j = 0; j < 16; ++j) { const f32x4 g = *(const GAS f32x4*)(F.gf + 4 * F.lane + 256 * j); xr[64 * j] = v[j] * rstd * g; }
    }
}

__device__ __forceinline__ void p3_conv_pool(Frame& F) {
    const int gt = blockIdx.x * (NWAVES * 64) + F.tid;
    for (int item = gt; item < (S / 16) * (CW / 8); item += F.G * NWAVES * 64) {
        const int c = (item & 255) * 8, t0 = (item >> 8) * 16;
        {
            float w0[8], w1[8], w2[8];
#pragma unroll
            for (int h = 0; h < 2; ++h) { const f32x4 a = *(const GAS f32x4*)(F.conv_w + c + 4 * h), b = *(const GAS f32x4*)(F.conv_w + CW + c + 4 * h), d = *(const GAS f32x4*)(F.conv_w + 2 * CW + c + 4 * h);
#pragma unroll
                for (int e = 0; e < 4; ++e) { w0[4 * h + e] = a[e]; w1[4 * h + e] = b[e]; w2[4 * h + e] = d[e]; } }
            float u1[8], u2[8];
#pragma unroll
            for (int e = 0; e < 8; ++e) { u1[e] = 0.f; u2[e] = 0.f; }
            if (t0 >= 2) {
                float a[8], b[8];
                unpack8(*(const GAS v4u*)(F.PROJ + (size_t)(t0 - 2) * INC + CW + c), a); unpack8(*(const GAS v4u*)(F.PROJ + (size_t)(t0 - 2) * INC + 2 * CW + c), b);
#pragma unroll
                for (int e = 0; e < 8; ++e) u2[e] = a[e] * b[e];
                unpack8(*(const GAS v4u*)(F.PROJ + (size_t)(t0 - 1) * INC + CW + c), a); unpack8(*(const GAS v4u*)(F.PROJ + (size_t)(t0 - 1) * INC + 2 * CW + c), b);
#pragma unroll
                for (int e = 0; e < 8; ++e) u1[e] = a[e] * b[e];
            }
#pragma unroll 4
            for (int i = 0; i < 16; ++i) { const bf16* rp = F.PROJ + (size_t)(t0 + i) * INC + c;
                float gb[8], gc[8], vv[8], o[8];
                unpack8(*(const GAS v4u*)(rp), gb); unpack8(*(const GAS v4u*)(rp + CW), gc); unpack8(*(const GAS v4u*)(rp + 2 * CW), vv);
#pragma unroll
                for (int e = 0; e < 8; ++e) { const float u0 = gc[e] * vv[e]; o[e] = gb[e] * (w0[e] * u2[e] + w1[e] * u1[e] + w2[e] * u0); u2[e] = u1[e]; u1[e] = u0; }
                *(GAS v4u*)(F.AM + (size_t)(t0 + i) * D + c) = pack8(o); }
        }
        {
            const int W = 2 << (c >> 9);
            const bf16* pp = F.PROJ + 3 * CW + c;
            float sum[8];
#pragma unroll
            for (int e = 0; e < 8; ++e) sum[e] = 0.f;
            for (int j = (t0 - W + 1 > 0 ? t0 - W + 1 : 0); j < t0; ++j) { float a[8]; unpack8(*(const GAS v4u*)(pp + (size_t)j * INC), a);
#pragma unroll
                for (int e = 0; e < 8; ++e) sum[e] += a[e]; }
#pragma unroll 4
            for (int i = 0; i < 16; ++i) { const int t = t0 + i; float pn[8], po[8], o[8];
                unpack8(*(const GAS v4u*)(pp + (size_t)t * INC), pn);
                const int told = t - W + 1;
                if (told >= 0) unpack8(*(const GAS v4u*)(pp + (size_t)told * INC), po); else {
#pragma unroll
                    for (int e = 0; e < 8; ++e) po[e] = 0.f; }
                const float inv = 1.f / (float)(t + 1 < W ? t + 1 : W);
#pragma unroll
                for (int e = 0; e < 8; ++e) { sum[e] += pn[e]; o[e] = sum[e] * inv - pn[e]; sum[e] -= po[e]; }
                *(GAS v4u*)(F.POOLED + (size_t)t * PW + c) = pack8(o); }
        }
    }
}

struct Args { const float* in[17]; float* out; unsigned char* ws; int ph_lo, ph_hi; };
__global__ void __launch_bounds__(NWAVES * 64, 2) mk_fwd(Args args) {
    extern __shared__ __attribute__((aligned(16))) unsigned char lds[];
    Frame F;
    F.lds = (LAS unsigned char*)lds;
    F.MISC = (volatile LAS unsigned*)(F.lds + MISC_OFF);
    F.tid = threadIdx.x; F.lane = F.tid & 63; F.wave = __builtin_amdgcn_readfirstlane(F.tid >> 6);
    F.G = gridDim.x; { const int bx = blockIdx.x; F.vcu = (F.G % 8 == 0) ? (bx % 8) * (F.G / 8) + bx / 8 : bx; }
    unsigned char* ws = args.ws;
    F.ctl = (gu32*)(ws + WS_CTL);
    F.x = args.in[0]; F.cvec = args.in[1]; F.w_ada = args.in[2]; F.b_ada = args.in[3]; F.g1 = args.in[4]; F.w_in = args.in[5]; F.gbias = args.in[6]; F.conv_w = args.in[7];
    F.w_conv_out = args.in[8]; F.w_pool_group = args.in[9]; F.pool_scale = args.in[10]; F.w_pool_out = args.in[11]; F.w_o = args.in[12]; F.g2 = args.in[13]; F.w_gate_up = args.in[14]; F.w_down = args.in[15]; F.gf = args.in[16];
    F.out = args.out;
    F.MODP = (float*)(ws + WS_MODP); F.MODF = (float*)(ws + WS_MODF); F.X1 = (float*)(ws + WS_X1);
    F.Win_t = (bf16*)(ws + WS_WIN); F.Wcp_t = (bf16*)(ws + WS_WCP); F.Wpg_t = (bf16*)(ws + WS_WPG); F.Wo_t = (bf16*)(ws + WS_WO); F.Wgu_t = (bf16*)(ws + WS_WGU); F.Wd_t = (bf16*)(ws + WS_WD);
    F.H = (bf16*)(ws + WS_H); F.PROJ = (bf16*)(ws + WS_PROJ); F.AM = (bf16*)(ws + WS_AM); F.POOLED = (bf16*)(ws + WS_POOLED); F.MERGED = (bf16*)(ws + WS_MERGED); F.H2 = (bf16*)(ws + WS_H2); F.ACT = (bf16*)(ws + WS_ACT);
    for (int u = F.tid; u < 32; u += NWAVES * 64) F.MISC[u] = 0u;
    __syncthreads();
    XcdBarrier bar; bar.bar = (unsigned*)(F.ctl + CW_BAR); bar.x = 0; bar.st = nullptr;
    if (N_LAUNCHES == 1) bar = xcd_barrier_post((unsigned*)(F.ctl + CW_BAR), F.MISC + 8);
#define GRID_BAR() do { if (N_LAUNCHES == 1) xcd_barrier(bar); } while (0)
    const int lo = args.ph_lo, hi = args.ph_hi;
#define IN(k) (lo <= (k) && (k) < hi)
#define BOTH(k) (IN(k) && IN((k) + 1))

    if (IN(0)) { p0_prologue(F); if (BOTH(0)) GRID_BAR(); }
    if (IN(1)) { p1_norm1(F); if (BOTH(1)) GRID_BAR(); }
    if (IN(2)) {
        pg8::Gemm g{D, D, D}; pg8::Order<0> O; O.init(S, INC, F.G, (int)blockIdx.x, F.H, F.Win_t, D, D);
        pg8::EpiBf16 E{F.PROJ, INC, nullptr};
        pg8::gemm_phase<pg8::EpiBf16, pg8::Order<0>>(F.lds + RING_OFF, g, O, E);
        if (BOTH(2)) GRID_BAR();
    }
    if (IN(3)) { p3_conv_pool(F); if (BOTH(3)) GRID_BAR(); }
    if (IN(4)) {
        pg8::Gemm g{PGRP, PW, PGRP}; pg8::Order<1> O; O.init(S, PW, F.G, (int)blockIdx.x, F.POOLED, F.Wpg_t, PW, PGRP);
        pg8::EpiBf16 E{F.AM + CW, D, F.pool_scale};
        pg8::gemm_phase<pg8::EpiBf16, pg8::Order<1>>(F.lds + RING_OFF, g, O, E);
        if (BOTH(4)) GRID_BAR();
    }
    if (IN(5)) {
        pg8::Gemm g{CW, D, D}; pg8::Order<2> O; O.init(S, D, F.G, (int)blockIdx.x, F.AM, F.Wcp_t, D, D);
        pg8::EpiMerge E{F.PROJ, F.gbias, F.MERGED};
        pg8::gemm_phase<pg8::EpiMerge, pg8::Order<2>>(F.lds + RING_OFF, g, O, E);
        if (BOTH(5)) GRID_BAR();
    }
    if (IN(6)) {
        pg8::Gemm g{D, D, D}; pg8::Order<0> O; O.init(S, D, F.G, (int)blockIdx.x, F.MERGED, F.Wo_t, D, D);
        pg8::EpiResid E{F.x, F.MODF + 2 * D, F.X1, D};
        pg8::gemm_phase<pg8::EpiResid, pg8::Order<0>>(F.lds + RING_OFF, g, O, E);
        if (BOTH(6)) GRID_BAR();
    }
    if (IN(7)) { p7_norm2(F); if (BOTH(7)) GRID_BAR(); }
    if (IN(8)) {
        pg8::Gemm g{D, D, D}; pg8::Order<0> O; O.init(S, 2 * FF, F.G, (int)blockIdx.x, F.H2, F.Wgu_t, D, D);
        pg8::EpiSwiglu E{F.ACT, FF};
        pg8::gemm_phase<pg8::EpiSwiglu, pg8::Order<0>>(F.lds + RING_OFF, g, O, E);
        if (BOTH(8)) GRID_BAR();
    }
    if (IN(9)) {
        pg8::Gemm g{FF, FF, FF}; pg8::Order<0> O; O.init(S, D, F.G, (int)blockIdx.x, F.ACT, F.Wd_t, FF, FF);
        pg8::EpiResid E{F.X1, F.MODF + 5 * D, F.out, D};
        pg8::gemm_phase<pg8::EpiResid, pg8::Order<0>>(F.lds + RING_OFF, g, O, E);
        if (BOTH(9)) GRID_BAR();
    }
    if (IN(10)) { p10_final_norm(F); }
#undef IN
#undef BOTH
#undef GRID_BAR
}

extern "C" void kernel_launch(void* const* d_in, const int* in_sizes, int n_in, void* d_out, int out_size, void* d_ws, size_t ws_size, hipStream_t stream) {
    static int grid = 0;
    if (grid == 0) {
        if (n_in != 17 || in_sizes[0] != S * D || out_size != S * D || ws_size < WS_END) { fprintf(stderr, "kernel_launch: unexpected shapes (n_in %d, in0 %d, out %d, ws %zu); nothing launched\n", n_in, n_in > 0 ? in_sizes[0] : -1, out_size, ws_size); grid = -1; return; }
        int dev = 0, cus = 0, per_cu = 0;
        if (hipGetDevice(&dev) != hipSuccess || hipDeviceGetAttribute(&cus, hipDeviceAttributeMultiprocessorCount, dev) != hipSuccess) { fprintf(stderr, "kernel_launch: device query failed\n"); grid = -1; return; }
        if (hipFuncSetAttribute((const void*)mk_fwd, hipFuncAttributeMaxDynamicSharedMemorySize, LDS_BYTES) != hipSuccess) { fprintf(stderr, "kernel_launch: hipFuncSetAttribute failed\n"); grid = -1; return; }
        if (hipOccupancyMaxActiveBlocksPerMultiprocessor(&per_cu, (const void*)mk_fwd, NWAVES * 64, LDS_BYTES) != hipSuccess || per_cu < 1)
            fprintf(stderr, "kernel_launch: note: occupancy query reports %d workgroups per CU\n", per_cu);
        (void)hipGetLastError();
        grid = cus;
    }
    if (grid < 0) return;
    if (hipMemsetAsync((char*)d_ws + WS_CTL, 0, CTL_ZERO_BYTES, stream) != hipSuccess) { fprintf(stderr, "kernel_launch: hipMemsetAsync failed\n"); return; }
    Args a{};
    for (int i = 0; i < 17; ++i) a.in[i] = (const float*)d_in[i];
    a.out = (float*)d_out; a.ws = (unsigned char*)d_ws;
    if (N_LAUNCHES == 1) { a.ph_lo = 0; a.ph_hi = PER_PHASE; hipLaunchKernelGGL(mk_fwd, dim3(grid), dim3(NWAVES * 64), LDS_BYTES, stream, a); }
    else for (int p = 0; p < PER_PHASE; ++p) { a.ph_lo = p; a.ph_hi = p + 1; hipLaunchKernelGGL(mk_fwd, dim3(grid), dim3(NWAVES * 64), LDS_BYTES, stream, a); }
    const hipError_t le = hipPeekAtLastError();
    if (le != hipSuccess) fprintf(stderr, "kernel_launch: launch failed: %s\n", hipGetErrorName(le));
}
```

```cpp
#include <hip/hip_runtime.h>
#include <cstdio>
#include <cstdint>

#ifndef PROBE_DUP
#define PROBE_DUP 0
#endif
#ifndef PROBE_ZERO
#define PROBE_ZERO 0
#endif
#ifndef MK_N_LAUNCHES
#define MK_N_LAUNCHES 1
#endif

namespace pg8 {
#define PG8_LAS __attribute__((address_space(3)))
typedef unsigned short bf16_t;
typedef short bf16x8 __attribute__((ext_vector_type(8)));
typedef float f32x4 __attribute__((ext_vector_type(4)));
typedef unsigned u32x4 __attribute__((ext_vector_type(4)));
constexpr int BM = 256, BK = 64, HALF = 128, HTB = HALF * BK * 2  , STAGE_BYTES = 8 * HTB, NXCD = 8, WGM = 8;

__host__ __device__ __forceinline__ int lds_byte(int r, int c) { const int st = (r >> 4) * 2 + (c >> 5), rr = r & 15, cc = c & 31, ob = rr * 64 + cc * 2; return st * 1024 + (ob ^ (((ob >> 9) & 1) << 5)); }
__host__ __device__ __forceinline__ void stage_rc(int b, int& R, int& C) { const int st = b / 1024, sb = b % 1024, swz = sb ^ (((sb >> 9) & 1) << 5); R = (st >> 1) * 16 + swz / 64; C = (st & 1) * 32 + (swz % 64) / 2; }
__host__ __device__ __forceinline__ int perm32(int rho) { const int n = rho >> 4, i = rho & 15; return 8 * (i >> 2) + 4 * n + (i & 3); }

struct Unit { int pm, pn, half; const char* a; const char* b; };
struct Gemm { int K, lda, ldb; };

template <int MODE> struct Order {
    int nM, nN, nwg, G, c; const char* A; const char* B; size_t a_tile, b_tile;
    __device__ __forceinline__ void init(int M, int N, int G_, int c_, const void* A_, const void* B_, int lda, int ldb) { nM = M / BM; nN = N / BM; nwg = nM * nN; G = G_; c = c_; A = (const char*)A_; B = (const char*)B_; a_tile = (size_t)BM * lda * 2; b_tile = (size_t)BM * ldb * 2; }
    __device__ __forceinline__ bool next(int i, Unit& u) const {
        const int ti = (MODE == 2) ? (i >> 1) : i;
        const long L = (long)ti * G + c; if (L >= nwg) return false;
        int wgid = (int)L; { const int q = nwg / NXCD, r = nwg % NXCD, xcd = wgid % NXCD, off = wgid / NXCD; wgid = (xcd < r ? xcd * (q + 1) : r * (q + 1) + (xcd - r) * q) + off; }
        const int nig = WGM * nN, gid = wgid / nig, fm = gid * WGM, gsz = (nM - fm) < WGM ? (nM - fm) : WGM;
        u.pm = fm + ((wgid % nig) % gsz); u.pn = (wgid % nig) / gsz; u.half = (MODE == 2) ? (i & 1) : 0;
        u.a = A + (size_t)u.pm * a_tile + (MODE == 1 ? (size_t)(u.pn >> 1) * 1024 : 0) + (MODE == 2 ? (size_t)u.half * 4096 : 0);
        u.b = B + (size_t)u.pn * b_tile + (MODE == 2 ? (size_t)u.half * 4096 : 0);
        return true;
    }
};

__device__ __forceinline__ unsigned cvt_pk_bf16(float lo, float hi) { unsigned r; asm volatile("v_cvt_pk_bf16_f32 %0, %1, %2" : "=v"(r) : "v"(lo), "v"(hi)); return r; }
__device__ __forceinline__ float bf_lo(unsigned w) { return __uint_as_float(w << 16); }
__device__ __forceinline__ float bf_hi(unsigned w) { return __uint_as_float(w & 0xffff0000u); }
__device__ __forceinline__ float exp_neg(float x) { return __builtin_amdgcn_exp2f(x * -1.44269504089f); }

struct EpiBf16 {
    static constexpr bool PERM = true;
    bf16_t* O; int ldc; const float* scale;
    __device__ __forceinline__ bool keep(const Unit&) const { return false; }
    __device__ __forceinline__ void operator()(f32x4 (&acc)[2][2][4][2], const Unit& u, int wr, int wc, int fr, int fq) const {
        const int row0 = u.pm * BM + wr * 64 + fr, col0 = u.pn * BM + wc * 32 + 8 * fq;
        f32x4 sv[2][2];
#pragma unroll
        for (int bj = 0; bj < 2; ++bj)
#pragma unroll
            for (int n = 0; n < 2; ++n) sv[bj][n] = scale ? *(const f32x4*)(scale + col0 + bj * HALF + 4 * n) : (f32x4){1.f, 1.f, 1.f, 1.f};
#pragma unroll
        for (int ai = 0; ai < 2; ++ai)
#pragma unroll
            for (int m = 0; m < 4; ++m) { bf16_t* rowp = O + (size_t)(row0 + ai * HALF + m * 16) * ldc + col0;
#pragma unroll
                for (int bj = 0; bj < 2; ++bj) { const f32x4 v0 = acc[ai][bj][m][0] * sv[bj][0], v1 = acc[ai][bj][m][1] * sv[bj][1];
                    u32x4 w; w.x = cvt_pk_bf16(v0[0], v0[1]); w.y = cvt_pk_bf16(v0[2], v0[3]); w.z = cvt_pk_bf16(v1[0], v1[1]); w.w = cvt_pk_bf16(v1[2], v1[3]);
                    *(u32x4*)(rowp + bj * HALF) = w; } }
    }
};
struct EpiMerge {
    static constexpr bool PERM = true;
    const bf16_t* proj; const float* gbias; bf16_t* O;
    __device__ __forceinline__ bool keep(const Unit& u) const { return u.half == 0; }
    __device__ __forceinline__ void operator()(f32x4 (&acc)[2][2][4][2], const Unit& u, int wr, int wc, int fr, int fq) const {
        const int row0 = u.pm * BM + wr * 64 + fr, col0 = u.pn * BM + wc * 32 + 8 * fq;
#pragma unroll
        for (int bj = 0; bj < 2; ++bj) {
            const int col = col0 + bj * HALF;
            const f32x4 bp0 = *(const f32x4*)(gbias + 4096 + col), bp1 = *(const f32x4*)(gbias + 4096 + col + 4);
            if (u.half == 0) {
                const f32x4 bc0 = *(const f32x4*)(gbias + col), bc1 = *(const f32x4*)(gbias + col + 4);
#pragma unroll
                for (int ai = 0; ai < 2; ++ai)
#pragma unroll
                    for (int m = 0; m < 4; ++m) { const bf16_t* rp = proj + (size_t)(row0 + ai * HALF + m * 16) * 16384 + col;
                        const u32x4 gc = *(const u32x4*)(rp + 8192), gp = *(const u32x4*)(rp + 12288);
#pragma unroll
                        for (int e = 0; e < 4; ++e) {
                            const float a0 = fmaxf(bf_lo(gc[e]) + (e < 2 ? bc0[2 * e] : bc1[2 * e - 4]), -60.f), a1 = fmaxf(bf_hi(gc[e]) + (e < 2 ? bc0[2 * e + 1] : bc1[2 * e - 3]), -60.f);
                            const float b0 = fmaxf(bf_lo(gp[e]) + (e < 2 ? bp0[2 * e] : bp1[2 * e - 4]), -60.f), b1 = fmaxf(bf_hi(gp[e]) + (e < 2 ? bp0[2 * e + 1] : bp1[2 * e - 3]), -60.f);
                            const float r0 = (1.f + exp_neg(b0)) * __builtin_amdgcn_rcpf(1.f + exp_neg(a0)), r1 = (1.f + exp_neg(b1)) * __builtin_amdgcn_rcpf(1.f + exp_neg(a1));
                            if (e < 2) { acc[ai][bj][m][0][2 * e] *= r0; acc[ai][bj][m][0][2 * e + 1] *= r1; } else { acc[ai][bj][m][1][2 * e - 4] *= r0; acc[ai][bj][m][1][2 * e - 3] *= r1; } } }
            } else {
#pragma unroll
                for (int ai = 0; ai < 2; ++ai)
#pragma unroll
                    for (int m = 0; m < 4; ++m) { const size_t row = (size_t)(row0 + ai * HALF + m * 16);
                        const u32x4 gp = *(const u32x4*)(proj + row * 16384 + 12288 + col); float s[8];
#pragma unroll
                        for (int e = 0; e < 4; ++e) {
                            const float b0 = fmaxf(bf_lo(gp[e]) + (e < 2 ? bp0[2 * e] : bp1[2 * e - 4]), -60.f), b1 = fmaxf(bf_hi(gp[e]) + (e < 2 ? bp0[2 * e + 1] : bp1[2 * e - 3]), -60.f);
                            s[2 * e] = __builtin_amdgcn_rcpf(1.f + exp_neg(b0)); s[2 * e + 1] = __builtin_amdgcn_rcpf(1.f + exp_neg(b1)); }
                        const f32x4 v0 = acc[ai][bj][m][0], v1 = acc[ai][bj][m][1];
                        u32x4 w; w.x = cvt_pk_bf16(v0[0] * s[0], v0[1] * s[1]); w.y = cvt_pk_bf16(v0[2] * s[2], v0[3] * s[3]); w.z = cvt_pk_bf16(v1[0] * s[4], v1[1] * s[5]); w.w = cvt_pk_bf16(v1[2] * s[6], v1[3] * s[7]);
                        *(u32x4*)(O + row * 4096 + col) = w; }
            }
        }
    }
};
struct EpiResid {
    static constexpr bool PERM = false;
    const float* base; const float* gate; float* out; int ldc;
    __device__ __forceinline__ bool keep(const Unit&) const { return false; }
    __device__ __forceinline__ void operator()(f32x4 (&acc)[2][2][4][2], const Unit& u, int wr, int wc, int fr, int fq) const {
        const int row0 = u.pm * BM + wr * 64 + fr, col0 = u.pn * BM + wc * 32 + 4 * fq;
        f32x4 gv[2][2];
#pragma unroll
        for (int bj = 0; bj < 2; ++bj)
#pragma unroll
            for (int n = 0; n < 2; ++n) gv[bj][n] = *(const f32x4*)(gate + col0 + bj * HALF + n * 16);
#pragma unroll
        for (int ai = 0; ai < 2; ++ai)
#pragma unroll
            for (int m = 0; m < 4; ++m) { const size_t off = (size_t)(row0 + ai * HALF + m * 16) * ldc + col0;
#pragma unroll
                for (int bj = 0; bj < 2; ++bj)
#pragma unroll
                    for (int n = 0; n < 2; ++n) { const f32x4 bs = *(const f32x4*)(base + off + bj * HALF + n * 16); *(f32x4*)(out + off + bj * HALF + n * 16) = bs + gv[bj][n] * acc[ai][bj][m][n]; }
                if (m & 1) asm volatile("" ::: "memory"); }
    }
};
struct EpiSwiglu {
    static constexpr bool PERM = true;
    bf16_t* O; int ldc;
    __device__ __forceinline__ bool keep(const Unit&) const { return false; }
    __device__ __forceinline__ void operator()(f32x4 (&acc)[2][2][4][2], const Unit& u, int wr, int wc, int fr, int fq) const {
        const int row0 = u.pm * BM + wr * 64 + fr, col0 = u.pn * HALF + wc * 32 + 8 * fq;
#pragma unroll
        for (int ai = 0; ai < 2; ++ai)
#pragma unroll
            for (int m = 0; m < 4; ++m) { float o[8];
#pragma unroll
                for (int n = 0; n < 2; ++n)
#pragma unroll
                    for (int e = 0; e < 4; ++e) { const float g = acc[ai][0][m][n][e], up = acc[ai][1][m][n][e]; o[4 * n + e] = g * __builtin_amdgcn_rcpf(1.f + exp_neg(g)) * up; }
                u32x4 w; w.x = cvt_pk_bf16(o[0], o[1]); w.y = cvt_pk_bf16(o[2], o[3]); w.z = cvt_pk_bf16(o[4], o[5]); w.w = cvt_pk_bf16(o[6], o[7]);
                *(u32x4*)(O + (size_t)(row0 + ai * HALF + m * 16) * ldc + col0) = w; }
    }
};

#ifndef CFG_ALIGN
#define CFG_ALIGN true
#endif
#ifndef CFG_SP2
#define CFG_SP2 true
#endif
template <class Epi, class Sched, bool ALIGN_EPI = CFG_ALIGN, bool SP2 = CFG_SP2>
__device__ __forceinline__ void gemm_phase(PG8_LAS unsigned char* lds, const Gemm g, const Sched& S, const Epi& E) {
    const int tid = threadIdx.x, wid = __builtin_amdgcn_readfirstlane(tid >> 6), lane = tid & 63, wr = wid >> 2, wc = wid & 3, fr = lane & 15, fq = lane >> 4;
    const int K = g.K, nt = K / BK;
    unsigned voffA[2], voffB[2];
#pragma unroll
    for (int i = 0; i < 2; ++i) { int R, C; stage_rc(tid * 16 + i * 8192, R, C); const int Rb = Epi::PERM ? ((R & ~31) + perm32(R & 31)) : R;
        voffA[i] = (unsigned)(R * g.lda + C) * 2u; voffB[i] = (unsigned)(Rb * g.ldb + C) * 2u; }
    const size_t kstep = (size_t)(BK * 2);
    const size_t hstepA = (size_t)HALF * g.lda * 2, hstepB = (size_t)HALF * g.ldb * 2;
    const unsigned ldsw = (unsigned)wid * 1024u;
    const int aoff = lds_byte(wr * 64 + fr, fq * 8), boff = lds_byte(wc * 32 + fr, fq * 8);
#define PG8_SA(b, h) (((b) * 2 + (h)) * HTB)
#define PG8_SB(b, h) ((4 + (b) * 2 + (h)) * HTB)
#define PG8_STAGE(bufoff, gbase, voff) do { _Pragma("unroll") for (int _i = 0; _i < 2; ++_i) \
        __builtin_amdgcn_global_load_lds((const unsigned*)((const char*)(gbase) + (voff)[_i]), (PG8_LAS unsigned*)(lds + (bufoff) + ldsw + _i * 8192), 16, 0, 0); } while (0)
#define PG8_LDA(dst, b, h) do { _Pragma("unroll") for (int m = 0; m < 4; ++m) _Pragma("unroll") for (int k = 0; k < 2; ++k) dst[m][k] = *(const PG8_LAS bf16x8*)(lds + PG8_SA(b, h) + aoff + m * 2048 + k * 1024); } while (0)
#define PG8_LDB(dst, b, h) do { _Pragma("unroll") for (int n = 0; n < 2; ++n) _Pragma("unroll") for (int k = 0; k < 2; ++k) dst[n][k] = *(const PG8_LAS bf16x8*)(lds + PG8_SB(b, h) + boff + n * 2048 + k * 1024); } while (0)
#define PG8_MMA(ai, bj, At, Bt) do { __builtin_amdgcn_s_setprio(1); _Pragma("unroll") for (int m = 0; m < 4; ++m) _Pragma("unroll") for (int n = 0; n < 2; ++n) _Pragma("unroll") for (int k = 0; k < 2; ++k) \
        acc[ai][bj][m][n] = __builtin_amdgcn_mfma_f32_16x16x32_bf16(Bt[n][k], At[m][k], acc[ai][bj][m][n], 0, 0, 0); __builtin_amdgcn_s_setprio(0); } while (0)
#define PG8_WAIT_V(n) asm volatile("s_waitcnt vmcnt(" #n ")" ::: "memory")
#define PG8_WAIT_L(n) asm volatile("s_waitcnt lgkmcnt(" #n ")" ::: "memory")
#define PG8_BAR __builtin_amdgcn_s_barrier()
#define PG8_SCHED __builtin_amdgcn_sched_barrier(0)
    Unit cur, nxt; int ui = 0;
    if (!S.next(0, cur)) return;
    f32x4 acc[2][2][4][2];
#pragma unroll
    for (int a = 0; a < 2; ++a)
#pragma unroll
        for (int b = 0; b < 2; ++b)
#pragma unroll
            for (int m = 0; m < 4; ++m)
#pragma unroll
                for (int n = 0; n < 2; ++n) acc[a][b][m][n] = (f32x4){0.f, 0.f, 0.f, 0.f};
    bf16x8 At[4][2], B0[2][2], B1[2][2];
    const char* cA = cur.a; const char* cB = cur.b;
    if constexpr (SP2) {
        PG8_STAGE(PG8_SB(0, 0), cB, voffB); PG8_STAGE(PG8_SB(0, 1), cB + hstepB, voffB); PG8_STAGE(PG8_SA(0, 0), cA, voffA); PG8_STAGE(PG8_SA(0, 1), cA + hstepA, voffA);
        if (wr == 1) PG8_BAR;
        PG8_WAIT_V(2); PG8_BAR;
        PG8_STAGE(PG8_SB(1, 0), cB + kstep, voffB); PG8_STAGE(PG8_SA(1, 0), cA + kstep, voffA); PG8_STAGE(PG8_SB(1, 1), cB + hstepB + kstep, voffB);
        PG8_WAIT_V(6); PG8_BAR;
    } else {
        PG8_STAGE(PG8_SB(0, 0), cB, voffB); PG8_STAGE(PG8_SA(0, 0), cA, voffA); PG8_STAGE(PG8_SB(0, 1), cB + hstepB, voffB); PG8_STAGE(PG8_SA(0, 1), cA + hstepA, voffA);
        if (wr == 1) PG8_BAR;
        PG8_WAIT_V(4); PG8_BAR;
        PG8_STAGE(PG8_SB(1, 0), cB + kstep, voffB); PG8_STAGE(PG8_SA(1, 0), cA + kstep, voffA); PG8_STAGE(PG8_SB(1, 1), cB + hstepB + kstep, voffB);
        PG8_WAIT_V(6); PG8_BAR;
    }
    for (;;) {
        const bool has_next = S.next(ui + 1, nxt);
        const char* nA = has_next ? nxt.a : cA; const char* nB = has_next ? nxt.b : cB;
        for (int t = 0; t < nt; t += 2) {
            const bool last = (t == nt - 2);
            const char* a1 = cA + (size_t)(t + 1) * kstep;
            const char* a2 = last ? nA : cA + (size_t)(t + 2) * kstep; const char* b2 = last ? nB : cB + (size_t)(t + 2) * kstep;
            const char* a3 = a2 + kstep; const char* b3 = b2 + kstep;
            if constexpr (SP2) {
            PG8_LDB(B0, 0, 0); PG8_LDB(B1, 0, 1); PG8_SCHED; PG8_LDA(At, 0, 0); PG8_STAGE(PG8_SA(1, 1), a1 + hstepA, voffA);
            PG8_WAIT_V(8); PG8_WAIT_L(0); PG8_BAR; PG8_MMA(0, 0, At, B0); PG8_MMA(0, 1, At, B1); PG8_BAR; PG8_SCHED;
            PG8_LDA(At, 0, 1); PG8_STAGE(PG8_SB(0, 0), b2, voffB); PG8_STAGE(PG8_SB(0, 1), b2 + hstepB, voffB); PG8_STAGE(PG8_SA(0, 0), a2, voffA);
            PG8_WAIT_V(8); PG8_WAIT_L(0); PG8_BAR; PG8_MMA(1, 0, At, B0); PG8_MMA(1, 1, At, B1); PG8_BAR; PG8_SCHED;
            PG8_LDB(B0, 1, 0); PG8_LDB(B1, 1, 1); PG8_SCHED; PG8_LDA(At, 1, 0); PG8_STAGE(PG8_SA(0, 1), a2 + hstepA, voffA);
            PG8_WAIT_V(8); PG8_WAIT_L(0); PG8_BAR; PG8_MMA(0, 0, At, B0); PG8_MMA(0, 1, At, B1); PG8_BAR; PG8_SCHED;
            PG8_LDA(At, 1, 1); PG8_STAGE(PG8_SB(1, 0), b3, voffB); PG8_STAGE(PG8_SB(1, 1), b3 + hstepB, voffB); PG8_STAGE(PG8_SA(1, 0), a3, voffA);
            PG8_WAIT_V(8); PG8_WAIT_L(0); PG8_BAR; PG8_MMA(1, 0, At, B0); PG8_MMA(1, 1, At, B1); PG8_BAR; PG8_SCHED;
            } else {
            PG8_LDB(B0, 0, 0); PG8_SCHED; PG8_LDA(At, 0, 0); PG8_STAGE(PG8_SA(1, 1), a1 + hstepA, voffA);
            PG8_WAIT_L(8); PG8_BAR; PG8_WAIT_L(0); PG8_MMA(0, 0, At, B0); PG8_BAR; PG8_SCHED;
            PG8_LDB(B1, 0, 1); PG8_STAGE(PG8_SB(0, 0), b2, voffB);
            PG8_BAR; PG8_WAIT_L(0); PG8_MMA(0, 1, At, B1); PG8_BAR;
            PG8_LDA(At, 0, 1); PG8_STAGE(PG8_SA(0, 0), a2, voffA);
            PG8_BAR; PG8_WAIT_L(0); PG8_MMA(1, 0, At, B0); PG8_BAR; PG8_SCHED;
            PG8_STAGE(PG8_SB(0, 1), b2 + hstepB, voffB);
            PG8_WAIT_V(6); PG8_BAR; PG8_MMA(1, 1, At, B1); PG8_BAR;
            PG8_LDB(B0, 1, 0); PG8_SCHED; PG8_LDA(At, 1, 0); PG8_STAGE(PG8_SA(0, 1), a2 + hstepA, voffA);
            PG8_WAIT_L(8); PG8_BAR; PG8_WAIT_L(0); PG8_MMA(0, 0, At, B0); PG8_BAR; PG8_SCHED;
            PG8_LDB(B1, 1, 1); PG8_STAGE(PG8_SB(1, 0), b3, voffB);
            PG8_BAR; PG8_WAIT_L(0); PG8_MMA(0, 1, At, B1); PG8_BAR;
            PG8_LDA(At, 1, 1); PG8_STAGE(PG8_SA(1, 0), a3, voffA);
            PG8_BAR; PG8_WAIT_L(0); PG8_MMA(1, 0, At, B0); PG8_BAR; PG8_SCHED;
            PG8_STAGE(PG8_SB(1, 1), b3 + hstepB, voffB);
            PG8_WAIT_V(6); PG8_BAR; PG8_MMA(1, 1, At, B1); PG8_BAR;
            }
        }
        if constexpr (ALIGN_EPI) { if (wr == 0) PG8_BAR; }
        E(acc, cur, wr, wc, fr, fq);
        if (!has_next) break;
        if (!E.keep(cur)) {
#pragma unroll
        for (int a = 0; a < 2; ++a)
#pragma unroll
            for (int b = 0; b < 2; ++b)
#pragma unroll
                for (int m = 0; m < 4; ++m)
#pragma unroll
                    for (int n = 0; n < 2; ++n) acc[a][b][m][n] = (f32x4){0.f, 0.f, 0.f, 0.f};
        }
        cur = nxt; cA = nA; cB = nB; ++ui;
        if constexpr (ALIGN_EPI) { if (wr == 1) PG8_BAR; }
    }
    PG8_WAIT_V(0);
    if constexpr (!ALIGN_EPI) { if (wr == 0) PG8_BAR; }
    PG8_BAR;
#undef PG8_SA
#undef PG8_SB
#undef PG8_STAGE
#undef PG8_LDA
#undef PG8_LDB
#undef PG8_MMA
#undef PG8_WAIT_V
#undef PG8_WAIT_L
#undef PG8_BAR
#undef PG8_SCHED
}
}

constexpr int NWAVES = 8;
constexpr int N_LAUNCHES = MK_N_LAUNCHES;
constexpr int PER_PHASE = 11;

constexpr int S = 8192, D = 4096, CW = 2048, PW = 2048, PGRP = 512, FF = 11008, INC = 16384, NMODV = 6 * D;
constexpr float EPS = 1e-6f;
constexpr int KSPLIT = 8;

constexpr size_t MiB = 1u << 20;
constexpr size_t WS_CTL = 0, CTL_ZERO_BYTES = 64 * 1024;
constexpr size_t WS_MODP = 1 * MiB;
constexpr size_t WS_MODF = WS_MODP + (size_t)KSPLIT * NMODV * 4;
constexpr size_t WS_WIN = 2 * MiB;
constexpr size_t WS_WCP = 130 * MiB;
constexpr size_t WS_WPG = 162 * MiB;
constexpr size_t WS_WO = 164 * MiB;
constexpr size_t WS_WGU = 196 * MiB;
constexpr size_t WS_WD = 368 * MiB;
constexpr size_t WS_H = 454 * MiB;
constexpr size_t WS_PROJ = 518 * MiB;
constexpr size_t WS_AM = 774 * MiB;
constexpr size_t WS_POOLED = 838 * MiB;
constexpr size_t WS_MERGED = 870 * MiB;
constexpr size_t WS_X1 = 934 * MiB;
constexpr size_t WS_H2 = 1062 * MiB;
constexpr size_t WS_ACT = 1126 * MiB;
constexpr size_t WS_END = 1298 * MiB;
static_assert(WS_MODF + NMODV * 4 <= WS_WIN && WS_ACT + (size_t)S * FF * 2 <= WS_END, "d_ws map");
constexpr int CW_QWD = 64;
constexpr int CW_BAR = 1024;
constexpr int RING_OFF = 0, RING_BYTES = 131072;
constexpr int LDSCTL_OFF = RING_BYTES + 8192, MISC_OFF = LDSCTL_OFF;
constexpr int LDS_BYTES = 147456;

#define GAS __attribute__((address_space(1)))
#define LAS __attribute__((address_space(3)))
typedef unsigned short bf16;
typedef unsigned v4u __attribute__((ext_vector_type(4)));
typedef float f32x4 __attribute__((ext_vector_type(4)));
typedef GAS unsigned gu32;
#define RLX_AGENT __ATOMIC_RELAXED, __HIP_MEMORY_SCOPE_AGENT
#define LDS_WAIT() asm volatile("s_waitcnt lgkmcnt(0)" ::: "memory")
__device__ __forceinline__ unsigned pk2(float lo, float hi) { return pg8::cvt_pk_bf16(lo, hi); }
__device__ __forceinline__ void unpack8(const v4u w, float (&f)[8]) {
#pragma unroll
    for (int e = 0; e < 4; ++e) { f[2 * e] = pg8::bf_lo(w[e]); f[2 * e + 1] = pg8::bf_hi(w[e]); } }
__device__ __forceinline__ v4u pack8(const float (&f)[8]) { v4u w; w.x = pk2(f[0], f[1]); w.y = pk2(f[2], f[3]); w.z = pk2(f[4], f[5]); w.w = pk2(f[6], f[7]); return w; }

#define XB_TMO      128
#define XB_XCNT(j)  (256  + 64 * (j))
#define XB_XSUB(j)  (1280 + 64 * (j))
#define XB_XGEN(j)  (2304 + 64 * (j))
#define XB_TOP      3328
#define XB_TOPGEN   3392
#define XCD_BAR_WORDS 3456
#define XB_SPIN_CAP (1u << 18)
static_assert((CW_BAR + XCD_BAR_WORDS) * 4 <= (int)CTL_ZERO_BYTES, "barrier words inside the memset region");

__device__ __forceinline__ unsigned xb_ld(unsigned* p)              { return __hip_atomic_load(p, __ATOMIC_RELAXED, __HIP_MEMORY_SCOPE_AGENT); }
__device__ __forceinline__ unsigned xb_add(unsigned* p, unsigned v) { return __hip_atomic_fetch_add(p, v, __ATOMIC_RELAXED, __HIP_MEMORY_SCOPE_AGENT); }
__device__ __forceinline__ unsigned xb_xcc_id() { return (unsigned)__builtin_amdgcn_s_getreg((3 << 11) | 20) & 0xFu; }
#define XB_SPIN(cond, bar) do { unsigned _sp = 0; while (cond) { __builtin_amdgcn_s_sleep(1); \
    if ((++_sp & 255u) == 0u) { if (xb_ld(&(bar)[XB_TMO])) break; if (_sp > XB_SPIN_CAP) { atomicAdd(&(bar)[XB_TMO], 1u); break; } } } } while (0)

struct XcdBarrier {
    unsigned* bar; unsigned x;
    volatile LAS unsigned* st;
};
__device__ __forceinline__ XcdBarrier xcd_barrier_post(unsigned* bar, volatile LAS unsigned* st) {
    XcdBarrier b; b.bar = bar; b.x = xb_xcc_id(); b.st = st;
    if (threadIdx.x == 0) (void)xb_add(&bar[XB_XCNT(b.x)], 1u);
    return b;
}
__device__ __forceinline__ void xcd_barrier_complete(unsigned* bar, unsigned x, unsigned& nloc, unsigned& nx) {
    const unsigned G = gridDim.x * gridDim.y * gridDim.z;
    unsigned sum, cnt, mine, sp = 0u;
    for (;;) {
        sum = 0u; cnt = 0u; mine = 0u;
#pragma unroll
        for (unsigned j = 0; j < 16; ++j) { const unsigned c = xb_ld(&bar[XB_XCNT(j)]); sum += c; cnt += (c > 0u) ? 1u : 0u; mine = (j == x) ? c : mine; }
        if (sum == G) break;
        __builtin_amdgcn_s_sleep(1);
        if ((++sp & 255u) == 0u) { if (xb_ld(&bar[XB_TMO])) break; if (sp > XB_SPIN_CAP) { atomicAdd(&bar[XB_TMO], 1u); break; } }
    }
    nloc = mine > 0u ? mine : 1u; nx = cnt > 0u ? cnt : 1u;
}
__device__ __forceinline__ void xcd_barrier(const XcdBarrier& b) {
    asm volatile("s_waitcnt vmcnt(0)" ::: "memory");
    __syncthreads();
    if (threadIdx.x == 0) {
        unsigned* bar = b.bar;
        __builtin_amdgcn_s_waitcnt(0);
        unsigned nloc = b.st[0], nx = b.st[1];
        if (nloc == 0u) { xcd_barrier_complete(bar, b.x, nloc, nx); b.st[0] = nloc; b.st[1] = nx; }
        const unsigned old = xb_add(&bar[XB_XSUB(b.x)], 1u);
        const unsigned gen = old / nloc;
        if (old + 1u == (gen + 1u) * nloc) {
            __builtin_amdgcn_fence(__ATOMIC_RELEASE, "agent");
            asm volatile("s_waitcnt vmcnt(0)" ::: "memory");
            const unsigned og = xb_add(&bar[XB_TOP], 1u);
            const unsigned tg = og / nx;
            if (og + 1u == (tg + 1u) * nx) xb_add(&bar[XB_TOPGEN], 1u);
            else XB_SPIN(xb_ld(&bar[XB_TOPGEN]) == tg, bar);
            __builtin_amdgcn_fence(__ATOMIC_ACQUIRE, "agent");
            xb_add(&bar[XB_XGEN(b.x)], 1u);
            asm volatile("s_waitcnt vmcnt(0)" ::: "memory");
        } else {
            XB_SPIN(xb_ld(&bar[XB_XGEN(b.x)]) == gen, bar);
            __builtin_amdgcn_fence(__ATOMIC_ACQUIRE, "agent");
            asm volatile("s_waitcnt vmcnt(0)" ::: "memory");
        }
    }
    __syncthreads();
}

struct Frame {
    LAS unsigned char* lds;
    volatile LAS unsigned* MISC;
    gu32* ctl;
    int tid, lane, wave;
    int vcu, G;
    const float *x, *cvec, *w_ada, *b_ada, *g1, *w_in, *gbias, *conv_w, *w_conv_out, *w_pool_group, *pool_scale, *w_pool_out, *w_o, *g2, *w_gate_up, *w_down, *gf;
    float* out;
    float *MODP, *MODF, *X1;
    bf16 *Win_t, *Wcp_t, *Wpg_t, *Wo_t, *Wgu_t, *Wd_t, *H, *PROJ, *AM, *POOLED, *MERGED, *H2, *ACT;
};

__device__ __forceinline__ float wave_sum(float v) {
#pragma unroll
    for (int o = 1; o < 64; o <<= 1) v += __shfl_xor(v, o);
    return v;
}

__device__ __forceinline__ void tr_item(const float* W, int N, int k0, int n0, bf16* dst, size_t dpitch, LAS float* scr, int lane) {
    const GAS f32x4* src = (const GAS f32x4*)(W + (size_t)(k0 + (lane >> 4)) * N + n0 + 4 * (lane & 15));
    f32x4 v[16];
#pragma unroll
    for (int i = 0; i < 16; ++i) v[i] = src[(size_t)i * N];
#pragma unroll
    for (int i = 0; i < 16; ++i) { LAS float* p = scr + (4 * i + (lane >> 4)) * 65 + 4 * (lane & 15); p[0] = v[i].x; p[1] = v[i].y; p[2] = v[i].z; p[3] = v[i].w; }
    LDS_WAIT(); asm volatile("" ::: "memory");
    const int c = lane >> 3;
#pragma unroll
    for (int j = 0; j < 8; ++j) { const int n = (lane & 7) + 8 * j; const LAS float* s = scr + (8 * c) * 65 + n;
        v4u o; o.x = pk2(s[0 * 65], s[1 * 65]); o.y = pk2(s[2 * 65], s[3 * 65]); o.z = pk2(s[4 * 65], s[5 * 65]); o.w = pk2(s[6 * 65], s[7 * 65]);
        *(GAS v4u*)(dst + (size_t)n * dpitch + 8 * c) = o; }
    LDS_WAIT(); asm volatile("" ::: "memory");
}

__device__ __forceinline__ void p0_prologue(Frame& F) {
    {
        LAS float* cs = (LAS float*)(F.lds);
        LAS float* red = (LAS float*)(F.lds + 16384);
        for (int i = F.tid; i < D; i += NWAVES * 64) { const float c = F.cvec[i]; cs[i] = c / (1.f + __expf(-c)); }
        __syncthreads();
        for (int it = blockIdx.x; it < 96 * KSPLIT; it += F.G) {
            const int cch = it % 96, kr = it / 96, rbase = kr * 512 + F.wave * 64;
            const float* wp = F.w_ada + (size_t)rbase * NMODV + cch * 256 + F.lane * 4;
            f32x4 a = (f32x4){0.f, 0.f, 0.f, 0.f};
#pragma unroll 1
            for (int r0 = 0; r0 < 64; r0 += 16) { f32x4 v[16];
#pragma unroll
                for (int q = 0; q < 16; ++q) v[q] = *(const GAS f32x4*)(wp + (size_t)(r0 + q) * NMODV);
#pragma unroll
                for (int q = 0; q < 16; ++q) a += v[q] * cs[rbase + r0 + q]; }
            *(LAS f32x4*)(red + F.wave * 256 + F.lane * 4) = a;
            __syncthreads();
            if (F.tid < 256) { float s = 0.f;
#pragma unroll
                for (int w = 0; w < 8; ++w) s += red[w * 256 + F.tid];
                F.MODP[(size_t)kr * NMODV + cch * 256 + F.tid] = s; }
            __syncthreads();
        }
    }
    LAS float* scr = (LAS float*)(F.lds + RING_OFF + F.wave * 16640);
    const int gw = F.vcu * NWAVES + F.wave, NGW = F.G * NWAVES;
    constexpr int I_IN = (D / 64) * (INC / 64), I_CV = (CW / 64) * (D / 64), I_PG = 4 * (PGRP / 64) * (PGRP / 64), I_O = (D / 64) * (D / 64), I_GU = (D / 64) * (2 * FF / 64), I_DN = (FF / 64) * (D / 64);
    constexpr int NITEMS = I_IN + 2 * I_CV + I_PG + I_O + I_GU;
    for (int it = gw; it < NITEMS; it += NGW) {
        int r = it;
        if (r < I_IN) { const int nb = INC / 64, kb = r / nb, n0 = (r % nb) * 64; tr_item(F.w_in, INC, kb * 64, n0, F.Win_t + (size_t)n0 * D + kb * 64, D, scr, F.lane); continue; } r -= I_IN;
        if (r < I_CV) { const int nb = D / 64, kb = r / nb, n0 = (r % nb) * 64; tr_item(F.w_conv_out, D, kb * 64, n0, F.Wcp_t + (size_t)n0 * D + kb * 64, D, scr, F.lane); continue; } r -= I_CV;
        if (r < I_CV) { const int nb = D / 64, kb = r / nb, n0 = (r % nb) * 64; tr_item(F.w_pool_out, D, kb * 64, n0, F.Wcp_t + (size_t)n0 * D + CW + kb * 64, D, scr, F.lane); continue; } r -= I_CV;
        if (r < I_PG) { const int g = r / 64, q = r % 64, kb = q / 8, n0 = (q % 8) * 64; tr_item(F.w_pool_group + (size_t)g * PGRP * PGRP, PGRP, kb * 64, n0, F.Wpg_t + (size_t)(g * PGRP + n0) * PGRP + kb * 64, PGRP, scr, F.lane); continue; } r -= I_PG;
        if (r < I_O) { const int nb = D / 64, kb = r / nb, n0 = (r % nb) * 64; tr_item(F.w_o, D, kb * 64, n0, F.Wo_t + (size_t)n0 * D + kb * 64, D, scr, F.lane); continue; } r -= I_O;
        if (r < I_GU) { const int nb = 2 * FF / 64, kb = r / nb, n0 = (r % nb) * 64; const int isup = n0 >= FF, nn = isup ? n0 - FF : n0, drow = (nn >> 7) * 256 + isup * 128 + (nn & 127);
            tr_item(F.w_gate_up, 2 * FF, kb * 64, n0, F.Wgu_t + (size_t)drow * D + kb * 64, D, scr, F.lane); }
    }
}
__device__ __forceinline__ void tr_load(const float* W, int N, int k0, int n0, int lane, f32x4 (&v)[16]) {
    const GAS f32x4* src = (const GAS f32x4*)(W + (size_t)(k0 + (lane >> 4)) * N + n0 + 4 * (lane & 15));
#pragma unroll
    for (int i = 0; i < 16; ++i) v[i] = src[(size_t)i * N];
}
__device__ __forceinline__ void tr_emit(const f32x4 (&v)[16], bf16* dst, size_t dpitch, LAS float* scr, int lane) {
#pragma unroll
    for (int i = 0; i < 16; ++i) { LAS float* p = scr + (4 * i + (lane >> 4)) * 65 + 4 * (lane & 15); p[0] = v[i].x; p[1] = v[i].y; p[2] = v[i].z; p[3] = v[i].w; }
    LDS_WAIT(); asm volatile("" ::: "memory");
    const int c = lane >> 3;
#pragma unroll
    for (int j = 0; j < 8; ++j) { const int n = (lane & 7) + 8 * j; const LAS float* s = scr + (8 * c) * 65 + n;
        v4u o; o.x = pk2(s[0 * 65], s[1 * 65]); o.y = pk2(s[2 * 65], s[3 * 65]); o.z = pk2(s[4 * 65], s[5 * 65]); o.w = pk2(s[6 * 65], s[7 * 65]);
        *(GAS v4u*)(dst + (size_t)n * dpitch + 8 * c) = o; }
    LDS_WAIT(); asm volatile("" ::: "memory");
}
__device__ __forceinline__ void p8_tail_convert_wd(Frame& F) {
    constexpr int I_DN = (FF / 64) * (D / 64), NB = D / 64;
    const int nunits = (S / 256) * (2 * FF / 256), rounds = (nunits + F.G - 1) / F.G, nshort = rounds * F.G - nunits;
    int w0, nw;
    if (nshort > 0) { if ((int)blockIdx.x < F.G - nshort) return; w0 = ((int)blockIdx.x - (F.G - nshort)) * NWAVES + F.wave; nw = nshort * NWAVES; }
    else { w0 = (int)blockIdx.x * NWAVES + F.wave; nw = F.G * NWAVES; }
    LAS float* scr = (LAS float*)(F.lds + RING_OFF + F.wave * 16640);
    f32x4 va[16], vb[16];
    int ia = w0;
    if (ia < I_DN) tr_load(F.w_down, D, (ia / NB) * 64, (ia % NB) * 64, F.lane, va);
    while (ia < I_DN) {
        const int ib = ia + nw;
        if (ib < I_DN) tr_load(F.w_down, D, (ib / NB) * 64, (ib % NB) * 64, F.lane, vb);
        tr_emit(va, F.Wd_t + (size_t)((ia % NB) * 64) * FF + (ia / NB) * 64, FF, scr, F.lane);
        if (ib >= I_DN) break;
        ia = ib + nw;
        if (ia < I_DN) tr_load(F.w_down, D, (ia / NB) * 64, (ia % NB) * 64, F.lane, va);
        tr_emit(vb, F.Wd_t + (size_t)((ib % NB) * 64) * FF + (ib / NB) * 64, FF, scr, F.lane);
    }
}

__device__ __forceinline__ void norm_rows_bf16(Frame& F, const float* src, bf16* dst, const LAS float* Amul, const LAS float* Badd) {
    const int gw = F.vcu * NWAVES + F.wave, NGW = F.G * NWAVES;
    for (int r = gw; r < S; r += NGW) {
        const GAS f32x4* xr = (const GAS f32x4*)(src + (size_t)r * D) + F.lane;
        f32x4 v[16]; float s = 0.f;
#pragma unroll
        for (int j = 0; j < 16; ++j) { v[j] = xr[64 * j]; s += (v[j].x * v[j].x + v[j].y * v[j].y) + (v[j].z * v[j].z + v[j].w * v[j].w); }
        const float rstd = 1.f / sqrtf(wave_sum(s) * (1.f / D) + EPS);
        GAS unsigned long long* o8 = (GAS unsigned long long*)(dst + (size_t)r * D) + F.lane;
#pragma unroll
        for (int j = 0; j < 16; ++j) { const f32x4 a = *(const LAS f32x4*)(Amul + 4 * F.lane + 256 * j), b = *(const LAS f32x4*)(Badd + 4 * F.lane + 256 * j);
            const f32x4 o = v[j] * rstd * a + b;
            o8[64 * j] = (unsigned long long)pk2(o.x, o.y) | ((unsigned long long)pk2(o.z, o.w) << 32); }
    }
}

__device__ __forceinline__ void p1_norm1(Frame& F) {
    LAS float* Amul = (LAS float*)(F.lds); LAS float* Badd = (LAS float*)(F.lds + 16384);
    for (int d = F.tid; d < D; d += NWAVES * 64) { float sh = F.b_ada[d], sc = F.b_ada[D + d];
#pragma unroll
        for (int p = 0; p < KSPLIT; ++p) { sh += F.MODP[(size_t)p * NMODV + d]; sc += F.MODP[(size_t)p * NMODV + D + d]; }
        Amul[d] = F.g1[d] * (1.f + sc); Badd[d] = sh; }
    { const int gt = blockIdx.x * (NWAVES * 64) + F.tid;
      for (int j = gt; j < NMODV; j += F.G * NWAVES * 64) { float s = F.b_ada[j];
#pragma unroll
          for (int p = 0; p < KSPLIT; ++p) s += F.MODP[(size_t)p * NMODV + j];
          F.MODF[j] = s; } }
    __syncthreads();
    norm_rows_bf16(F, F.x, F.H, Amul, Badd);
}
__device__ __forceinline__ void p7_norm2(Frame& F) {
    LAS float* Amul = (LAS float*)(F.lds); LAS float* Badd = (LAS float*)(F.lds + 16384);
    for (int d = F.tid; d < D; d += NWAVES * 64) { Amul[d] = F.g2[d] * (1.f + F.MODF[4 * D + d]); Badd[d] = F.MODF[3 * D + d]; }
    __syncthreads();
    norm_rows_bf16(F, F.X1, F.H2, Amul, Badd);
}
__device__ __forceinline__ void p10_final_norm(Frame& F) {
    const int gw = F.vcu * NWAVES + F.wave, NGW = F.G * NWAVES;
    for (int r = gw; r < S; r += NGW) {
        GAS f32x4* xr = (GAS f32x4*)(F.out + (size_t)r * D) + F.lane;
        f32x4 v[16]; float s = 0.f;
#pragma unroll
        for (int j = 0; j < 16; ++j) { v[j] = xr[64 * j]; s += (v[j].x * v[j].x + v[j].y * v[j].y) + (v[j].z * v[j].z + v[j].w * v[j].w); }
        const float rstd = 1.f / sqrtf(wave_sum(s) * (1.f / D) + EPS);
#pragma unroll
        for (int j = 0; j < 16; ++j) { const f32x4 g = *(const GAS f32x4*)(F.gf + 4 * F.lane + 256 * j); xr[64 * j] = v[j] * rstd * g; }
    }
}

__device__ __forceinline__ void p3_conv_pool(Frame& F) {
    const int gt = blockIdx.x * (NWAVES * 64) + F.tid;
    for (int item = gt; item < (S / 16) * (CW / 8); item += F.G * NWAVES * 64) {
        const int c = (item & 255) * 8, t0 = (item >> 8) * 16;
        {
            float w0[8], w1[8], w2[8];
#pragma unroll
            for (int h = 0; h < 2; ++h) { const f32x4 a = *(const GAS f32x4*)(F.conv_w + c + 4 * h), b = *(const GAS f32x4*)(F.conv_w + CW + c + 4 * h), d = *(const GAS f32x4*)(F.conv_w + 2 * CW + c + 4 * h);
#pragma unroll
                for (int e = 0; e < 4; ++e) { w0[4 * h + e] = a[e]; w1[4 * h + e] = b[e]; w2[4 * h + e] = d[e]; } }
            float u1[8], u2[8];
#pragma unroll
            for (int e = 0; e < 8; ++e) { u1[e] = 0.f; u2[e] = 0.f; }
            if (t0 >= 2) {
                float a[8], b[8];
                unpack8(*(const GAS v4u*)(F.PROJ + (size_t)(t0 - 2) * INC + CW + c), a); unpack8(*(const GAS v4u*)(F.PROJ + (size_t)(t0 - 2) * INC + 2 * CW + c), b);
#pragma unroll
                for (int e = 0; e < 8; ++e) u2[e] = a[e] * b[e];
                unpack8(*(const GAS v4u*)(F.PROJ + (size_t)(t0 - 1) * INC + CW + c), a); unpack8(*(const GAS v4u*)(F.PROJ + (size_t)(t0 - 1) * INC + 2 * CW + c), b);
#pragma unroll
                for (int e = 0; e < 8; ++e) u1[e] = a[e] * b[e];
            }
#pragma unroll 4
            for (int i = 0; i < 16; ++i) { const bf16* rp = F.PROJ + (size_t)(t0 + i) * INC + c;
                float gb[8], gc[8], vv[8], o[8];
                unpack8(*(const GAS v4u*)(rp), gb); unpack8(*(const GAS v4u*)(rp + CW), gc); unpack8(*(const GAS v4u*)(rp + 2 * CW), vv);
#pragma unroll
                for (int e = 0; e < 8; ++e) { const float u0 = gc[e] * vv[e]; o[e] = gb[e] * (w0[e] * u2[e] + w1[e] * u1[e] + w2[e] * u0); u2[e] = u1[e]; u1[e] = u0; }
                *(GAS v4u*)(F.AM + (size_t)(t0 + i) * D + c) = pack8(o); }
        }
        {
            const int W = 2 << (c >> 9);
            const bf16* pp = F.PROJ + 3 * CW + c;
            float sum[8];
#pragma unroll
            for (int e = 0; e < 8; ++e) sum[e] = 0.f;
            for (int j = (t0 - W + 1 > 0 ? t0 - W + 1 : 0); j < t0; ++j) { float a[8]; unpack8(*(const GAS v4u*)(pp + (size_t)j * INC), a);
#pragma unroll
                for (int e = 0; e < 8; ++e) sum[e] += a[e]; }
#pragma unroll 4
            for (int i = 0; i < 16; ++i) { const int t = t0 + i; float pn[8], po[8], o[8];
                unpack8(*(const GAS v4u*)(pp + (size_t)t * INC), pn);
                const int told = t - W + 1;
                if (told >= 0) unpack8(*(const GAS v4u*)(pp + (size_t)told * INC), po); else {
#pragma unroll
                    for (int e = 0; e < 8; ++e) po[e] = 0.f; }
                const float inv = 1.f / (float)(t + 1 < W ? t + 1 : W);
#pragma unroll
                for (int e = 0; e < 8; ++e) { sum[e] += pn[e]; o[e] = sum[e] * inv - pn[e]; sum[e] -= po[e]; }
                *(GAS v4u*)(F.POOLED + (size_t)t * PW + c) = pack8(o); }
        }
    }
}

struct Args { const float* in[17]; float* out; unsigned char* ws; int ph_lo, ph_hi; };
__global__ void __launch_bounds__(NWAVES * 64, 2) mk_fwd(Args args) {
    extern __shared__ __attribute__((aligned(16))) unsigned char lds[];
    Frame F;
    F.lds = (LAS unsigned char*)lds;
    F.MISC = (volatile LAS unsigned*)(F.lds + MISC_OFF);
    F.tid = threadIdx.x; F.lane = F.tid & 63; F.wave = __builtin_amdgcn_readfirstlane(F.tid >> 6);
    F.G = gridDim.x; { const int bx = blockIdx.x; F.vcu = (F.G % 8 == 0) ? (bx % 8) * (F.G / 8) + bx / 8 : bx; }
    unsigned char* ws = args.ws;
    F.ctl = (gu32*)(ws + WS_CTL);
    F.x = args.in[0]; F.cvec = args.in[1]; F.w_ada = args.in[2]; F.b_ada = args.in[3]; F.g1 = args.in[4]; F.w_in = args.in[5]; F.gbias = args.in[6]; F.conv_w = args.in[7];
    F.w_conv_out = args.in[8]; F.w_pool_group = args.in[9]; F.pool_scale = args.in[10]; F.w_pool_out = args.in[11]; F.w_o = args.in[12]; F.g2 = args.in[13]; F.w_gate_up = args.in[14]; F.w_down = args.in[15]; F.gf = args.in[16];
    F.out = args.out;
    F.MODP = (float*)(ws + WS_MODP); F.MODF = (float*)(ws + WS_MODF); F.X1 = (float*)(ws + WS_X1);
    F.Win_t = (bf16*)(ws + WS_WIN); F.Wcp_t = (bf16*)(ws + WS_WCP); F.Wpg_t = (bf16*)(ws + WS_WPG); F.Wo_t = (bf16*)(ws + WS_WO); F.Wgu_t = (bf16*)(ws + WS_WGU); F.Wd_t = (bf16*)(ws + WS_WD);
    F.H = (bf16*)(ws + WS_H); F.PROJ = (bf16*)(ws + WS_PROJ); F.AM = (bf16*)(ws + WS_AM); F.POOLED = (bf16*)(ws + WS_POOLED); F.MERGED = (bf16*)(ws + WS_MERGED); F.H2 = (bf16*)(ws + WS_H2); F.ACT = (bf16*)(ws + WS_ACT);
    for (int u = F.tid; u < 32; u += NWAVES * 64) F.MISC[u] = 0u;
    __syncthreads();
    XcdBarrier bar; bar.bar = (unsigned*)(F.ctl + CW_BAR); bar.x = 0; bar.st = nullptr;
    if (N_LAUNCHES == 1) bar = xcd_barrier_post((unsigned*)(F.ctl + CW_BAR), F.MISC + 8);
#define GRID_BAR() do { if (N_LAUNCHES == 1) xcd_barrier(bar); } while (0)
    const int lo = args.ph_lo, hi = args.ph_hi;
#define IN(k) (lo <= (k) && (k) < hi)
#define REPS(k) (((PROBE_DUP >> (k)) & 1) ? 2 : 1)
#define BOTH(k) (IN(k) && IN((k) + 1))

    if (IN(0)) { for (int rep = 0; rep < REPS(0); ++rep) { p0_prologue(F); __syncthreads(); } if (BOTH(0)) GRID_BAR(); }
    if (IN(1)) { for (int rep = 0; rep < REPS(1); ++rep) { p1_norm1(F); __syncthreads(); } if (BOTH(1)) GRID_BAR(); }
    if (IN(2)) {
        pg8::Gemm g{D, D, D}; pg8::Order<0> O; O.init(S, INC, F.G, (int)blockIdx.x, F.H, F.Win_t, D, D);
        pg8::EpiBf16 E{F.PROJ, INC, nullptr};
        if (PROBE_ZERO) { pg8::Order<0> OZ; OZ.init(S, INC, F.G, (int)blockIdx.x, ws + WS_END, ws + WS_END + 64 * MiB, D, D); pg8::gemm_phase<pg8::EpiBf16, pg8::Order<0>>(F.lds + RING_OFF, g, OZ, E); }
        for (int rep = 0; rep < REPS(2); ++rep) pg8::gemm_phase<pg8::EpiBf16, pg8::Order<0>>(F.lds + RING_OFF, g, O, E);
        if (BOTH(2)) GRID_BAR();
    }
    if (IN(3)) { for (int rep = 0; rep < REPS(3); ++rep) p3_conv_pool(F); if (BOTH(3)) GRID_BAR(); }
    if (IN(4)) {
        pg8::Gemm g{PGRP, PW, PGRP}; pg8::Order<1> O; O.init(S, PW, F.G, (int)blockIdx.x, F.POOLED, F.Wpg_t, PW, PGRP);
        pg8::EpiBf16 E{F.AM + CW, D, F.pool_scale};
        for (int rep = 0; rep < REPS(4); ++rep) pg8::gemm_phase<pg8::EpiBf16, pg8::Order<1>>(F.lds + RING_OFF, g, O, E);
        if (BOTH(4)) GRID_BAR();
    }
    if (IN(5)) {
        pg8::Gemm g{CW, D, D}; pg8::Order<2> O; O.init(S, D, F.G, (int)blockIdx.x, F.AM, F.Wcp_t, D, D);
        pg8::EpiMerge E{F.PROJ, F.gbias, F.MERGED};
        for (int rep = 0; rep < REPS(5); ++rep) pg8::gemm_phase<pg8::EpiMerge, pg8::Order<2>>(F.lds + RING_OFF, g, O, E);
        if (BOTH(5)) GRID_BAR();
    }
    if (IN(6)) {
        pg8::Gemm g{D, D, D}; pg8::Order<0> O; O.init(S, D, F.G, (int)blockIdx.x, F.MERGED, F.Wo_t, D, D);
        pg8::EpiResid E{F.x, F.MODF + 2 * D, F.X1, D};
        for (int rep = 0; rep < REPS(6); ++rep) pg8::gemm_phase<pg8::EpiResid, pg8::Order<0>>(F.lds + RING_OFF, g, O, E);
        if (BOTH(6)) GRID_BAR();
    }
    if (IN(7)) { for (int rep = 0; rep < REPS(7); ++rep) { p7_norm2(F); __syncthreads(); } if (BOTH(7)) GRID_BAR(); }
    if (IN(8)) {
        pg8::Gemm g{D, D, D}; pg8::Order<0> O; O.init(S, 2 * FF, F.G, (int)blockIdx.x, F.H2, F.Wgu_t, D, D);
        pg8::EpiSwiglu E{F.ACT, FF};
        for (int rep = 0; rep < REPS(8); ++rep) pg8::gemm_phase<pg8::EpiSwiglu, pg8::Order<0>>(F.lds + RING_OFF, g, O, E);
        p8_tail_convert_wd(F);
        if (BOTH(8)) GRID_BAR();
    }
    if (IN(9)) {
        pg8::Gemm g{FF, FF, FF}; pg8::Order<0> O; O.init(S, D, F.G, (int)blockIdx.x, F.ACT, F.Wd_t, FF, FF);
        pg8::EpiResid E{F.X1, F.MODF + 5 * D, F.out, D};
        for (int rep = 0; rep < REPS(9); ++rep) pg8::gemm_phase<pg8::EpiResid, pg8::Order<0>>(F.lds + RING_OFF, g, O, E);
        if (BOTH(9)) GRID_BAR();
    }
    if (IN(10)) { p10_final_norm(F); }
#undef IN
#undef BOTH
#undef GRID_BAR
}

extern "C" void kernel_launch(void* const* d_in, const int* in_sizes, int n_in, void* d_out, int out_size, void* d_ws, size_t ws_size, hipStream_t stream) {
    static int grid = 0;
    if (grid == 0) {
        if (n_in != 17 || in_sizes[0] != S * D || out_size != S * D || ws_size < WS_END) { fprintf(stderr, "kernel_launch: unexpected shapes (n_in %d, in0 %d, out %d, ws %zu); nothing launched\n", n_in, n_in > 0 ? in_sizes[0] : -1, out_size, ws_size); grid = -1; return; }
        int dev = 0, cus = 0, per_cu = 0;
        if (hipGetDevice(&dev) != hipSuccess || hipDeviceGetAttribute(&cus, hipDeviceAttributeMultiprocessorCount, dev) != hipSuccess) { fprintf(stderr, "kernel_launch: device query failed\n"); grid = -1; return; }
        if (hipFuncSetAttribute((const void*)mk_fwd, hipFuncAttributeMaxDynamicSharedMemorySize, LDS_BYTES) != hipSuccess) { fprintf(stderr, "kernel_launch: hipFuncSetAttribute failed\n"); grid = -1; return; }
        if (hipOccupancyMaxActiveBlocksPerMultiprocessor(&per_cu, (const void*)mk_fwd, NWAVES * 64, LDS_BYTES) != hipSuccess || per_cu < 1)
            fprintf(stderr, "kernel_launch: note: occupancy query reports %d workgroups per CU\n", per_cu);
        (void)hipGetLastError();
        grid = cus;
    }
    if (grid < 0) return;
    if (hipMemsetAsync((char*)d_ws + WS_CTL, 0, CTL_ZERO_BYTES, stream) != hipSuccess) { fprintf(stderr, "kernel_launch: hipMemsetAsync failed\n"); return; }
    if (PROBE_ZERO) (void)hipMemsetAsync((char*)d_ws + WS_END, 0, 192 * MiB, stream);
    Args a{};
    for (int i = 0; i < 17; ++i) a.in[i] = (const float*)d_in[i];
    a.out = (float*)d_out; a.ws = (unsigned char*)d_ws;
    if (N_LAUNCHES == 1) { a.ph_lo = 0; a.ph_hi = PER_PHASE; hipLaunchKernelGGL(mk_fwd, dim3(grid), dim3(NWAVES * 64), LDS_BYTES, stream, a); }
    else for (int p = 0; p < PER_PHASE; ++p) { a.ph_lo = p; a.ph_hi = p + 1; hipLaunchKernelGGL(mk_fwd, dim3(grid), dim3(NWAVES * 64), LDS_BYTES, stream, a); }
    const hipError_t le = hipPeekAtLastError();
    if (le != hipSuccess) fprintf(stderr, "kernel_launch: launch failed: %s\n", hipGetErrorName(le));
}
```

```cpp
#include <hip/hip_runtime.h>
#include <cstdio>
#include <cstdint>

#ifndef PROBE_DUP
#define PROBE_DUP 0
#endif
#ifndef PROBE_ZERO
#define PROBE_ZERO 0
#endif
#ifndef PROBE_SUB
#define PROBE_SUB 0
#endif
#ifndef MK_N_LAUNCHES
#define MK_N_LAUNCHES 1
#endif

namespace pg8 {
#define PG8_LAS __attribute__((address_space(3)))
typedef unsigned short bf16_t;
typedef short bf16x8 __attribute__((ext_vector_type(8)));
typedef float f32x4 __attribute__((ext_vector_type(4)));
typedef unsigned u32x4 __attribute__((ext_vector_type(4)));
constexpr int BM = 256, BK = 64, HALF = 128, HTB = HALF * BK * 2  , STAGE_BYTES = 8 * HTB, NXCD = 8;

__host__ __device__ __forceinline__ int lds_byte(int r, int c) { const int st = (r >> 4) * 2 + (c >> 5), rr = r & 15, cc = c & 31, ob = rr * 64 + cc * 2; return st * 1024 + (ob ^ (((ob >> 9) & 1) << 5)); }
__host__ __device__ __forceinline__ void stage_rc(int b, int& R, int& C) { const int st = b / 1024, sb = b % 1024, swz = sb ^ (((sb >> 9) & 1) << 5); R = (st >> 1) * 16 + swz / 64; C = (st & 1) * 32 + (swz % 64) / 2; }
__host__ __device__ __forceinline__ int perm32(int rho) { const int n = rho >> 4, i = rho & 15; return 8 * (i >> 2) + 4 * n + (i & 3); }

struct Unit { int pm, pn, half; const char* a; const char* b; };
struct Gemm { int K, lda, ldb; };

#ifndef CFG_STAGGER
#define CFG_STAGGER 0
#endif
template <int MODE, int WGM> struct Order {
    int nM, nN, nwg, G, c; const char* A; const char* B; size_t a_tile, b_tile;
    __device__ __forceinline__ void init(int M, int N, int G_, int c_, const void* A_, const void* B_, int lda, int ldb) { nM = M / BM; nN = N / BM; nwg = nM * nN; G = G_; c = c_; A = (const char*)A_; B = (const char*)B_; a_tile = (size_t)BM * lda * 2; b_tile = (size_t)BM * ldb * 2; }
    __device__ __forceinline__ bool next(int i, Unit& u) const {
        const int ti = (MODE == 2) ? (i >> 1) : i;
        const long L = (long)ti * G + c; if (L >= nwg) return false;
        int wgid = (int)L; const int xcd = wgid % NXCD; { const int q = nwg / NXCD, r = nwg % NXCD, off = wgid / NXCD; wgid = (xcd < r ? xcd * (q + 1) : r * (q + 1) + (xcd - r) * q) + off; }
        const int nig = WGM * nN, gid = wgid / nig, fm = gid * WGM, gsz = (nM - fm) < WGM ? (nM - fm) : WGM;
        u.pm = fm + ((wgid % nig) % gsz); u.pn = (wgid % nig) / gsz; u.half = (MODE == 2) ? (i & 1) : 0;
        if (CFG_STAGGER) u.pn = (u.pn + xcd * (nN / NXCD)) % nN;
        u.a = A + (size_t)u.pm * a_tile + (MODE == 1 ? (size_t)(u.pn >> 1) * 1024 : 0) + (MODE == 2 ? (size_t)u.half * 4096 : 0);
        u.b = B + (size_t)u.pn * b_tile + (MODE == 2 ? (size_t)u.half * 4096 : 0);
        return true;
    }
};

__device__ __forceinline__ unsigned cvt_pk_bf16(float lo, float hi) { unsigned r; asm volatile("v_cvt_pk_bf16_f32 %0, %1, %2" : "=v"(r) : "v"(lo), "v"(hi)); return r; }
__device__ __forceinline__ float bf_lo(unsigned w) { return __uint_as_float(w << 16); }
__device__ __forceinline__ float bf_hi(unsigned w) { return __uint_as_float(w & 0xffff0000u); }
__device__ __forceinline__ float exp_neg(float x) { return __builtin_amdgcn_exp2f(x * -1.44269504089f); }

struct EpiBf16 {
    static constexpr bool PERM = true;
    bf16_t* O; int ldc; const float* scale;
    __device__ __forceinline__ bool keep(const Unit&) const { return false; }
    __device__ __forceinline__ void operator()(f32x4 (&acc)[2][2][4][2], const Unit& u, int wr, int wc, int fr, int fq) const {
        const int row0 = u.pm * BM + wr * 64 + fr, col0 = u.pn * BM + wc * 32 + 8 * fq;
        f32x4 sv[2][2];
#pragma unroll
        for (int bj = 0; bj < 2; ++bj)
#pragma unroll
            for (int n = 0; n < 2; ++n) sv[bj][n] = scale ? *(const f32x4*)(scale + col0 + bj * HALF + 4 * n) : (f32x4){1.f, 1.f, 1.f, 1.f};
#pragma unroll
        for (int ai = 0; ai < 2; ++ai)
#pragma unroll
            for (int m = 0; m < 4; ++m) { bf16_t* rowp = O + (size_t)(row0 + ai * HALF + m * 16) * ldc + col0;
#pragma unroll
                for (int bj = 0; bj < 2; ++bj) { const f32x4 v0 = acc[ai][bj][m][0] * sv[bj][0], v1 = acc[ai][bj][m][1] * sv[bj][1];
                    u32x4 w; w.x = cvt_pk_bf16(v0[0], v0[1]); w.y = cvt_pk_bf16(v0[2], v0[3]); w.z = cvt_pk_bf16(v1[0], v1[1]); w.w = cvt_pk_bf16(v1[2], v1[3]);
                    *(u32x4*)(rowp + bj * HALF) = w; } }
    }
};
struct EpiMerge {
    static constexpr bool PERM = true;
    const bf16_t* proj; const float* gbias; bf16_t* O;
    __device__ __forceinline__ bool keep(const Unit& u) const { return u.half == 0; }
    __device__ __forceinline__ void operator()(f32x4 (&acc)[2][2][4][2], const Unit& u, int wr, int wc, int fr, int fq) const {
        const int row0 = u.pm * BM + wr * 64 + fr, col0 = u.pn * BM + wc * 32 + 8 * fq;
#pragma unroll
        for (int bj = 0; bj < 2; ++bj) {
            const int col = col0 + bj * HALF;
            const f32x4 bp0 = *(const f32x4*)(gbias + 4096 + col), bp1 = *(const f32x4*)(gbias + 4096 + col + 4);
            if (u.half == 0) {
                const f32x4 bc0 = *(const f32x4*)(gbias + col), bc1 = *(const f32x4*)(gbias + col + 4);
#pragma unroll
                for (int ai = 0; ai < 2; ++ai)
#pragma unroll
                    for (int m = 0; m < 4; ++m) { const bf16_t* rp = proj + (size_t)(row0 + ai * HALF + m * 16) * 16384 + col;
                        const u32x4 gc = *(const u32x4*)(rp + 8192), gp = *(const u32x4*)(rp + 12288);
#pragma unroll
                        for (int e = 0; e < 4; ++e) {
                            const float a0 = fmaxf(bf_lo(gc[e]) + (e < 2 ? bc0[2 * e] : bc1[2 * e - 4]), -60.f), a1 = fmaxf(bf_hi(gc[e]) + (e < 2 ? bc0[2 * e + 1] : bc1[2 * e - 3]), -60.f);
                            const float b0 = fmaxf(bf_lo(gp[e]) + (e < 2 ? bp0[2 * e] : bp1[2 * e - 4]), -60.f), b1 = fmaxf(bf_hi(gp[e]) + (e < 2 ? bp0[2 * e + 1] : bp1[2 * e - 3]), -60.f);
                            const float r0 = (1.f + exp_neg(b0)) * __builtin_amdgcn_rcpf(1.f + exp_neg(a0)), r1 = (1.f + exp_neg(b1)) * __builtin_amdgcn_rcpf(1.f + exp_neg(a1));
                            if (e < 2) { acc[ai][bj][m][0][2 * e] *= r0; acc[ai][bj][m][0][2 * e + 1] *= r1; } else { acc[ai][bj][m][1][2 * e - 4] *= r0; acc[ai][bj][m][1][2 * e - 3] *= r1; } } }
            } else {
#pragma unroll
                for (int ai = 0; ai < 2; ++ai)
#pragma unroll
                    for (int m = 0; m < 4; ++m) { const size_t row = (size_t)(row0 + ai * HALF + m * 16);
                        const u32x4 gp = *(const u32x4*)(proj + row * 16384 + 12288 + col); float s[8];
#pragma unroll
                        for (int e = 0; e < 4; ++e) {
                            const float b0 = fmaxf(bf_lo(gp[e]) + (e < 2 ? bp0[2 * e] : bp1[2 * e - 4]), -60.f), b1 = fmaxf(bf_hi(gp[e]) + (e < 2 ? bp0[2 * e + 1] : bp1[2 * e - 3]), -60.f);
                            s[2 * e] = __builtin_amdgcn_rcpf(1.f + exp_neg(b0)); s[2 * e + 1] = __builtin_amdgcn_rcpf(1.f + exp_neg(b1)); }
                        const f32x4 v0 = acc[ai][bj][m][0], v1 = acc[ai][bj][m][1];
                        u32x4 w; w.x = cvt_pk_bf16(v0[0] * s[0], v0[1] * s[1]); w.y = cvt_pk_bf16(v0[2] * s[2], v0[3] * s[3]); w.z = cvt_pk_bf16(v1[0] * s[4], v1[1] * s[5]); w.w = cvt_pk_bf16(v1[2] * s[6], v1[3] * s[7]);
                        *(u32x4*)(O + row * 4096 + col) = w; }
            }
        }
    }
};
struct EpiResid {
    static constexpr bool PERM = false;
    const float* base; const float* gate; float* out; int ldc;
    __device__ __forceinline__ bool keep(const Unit&) const { return false; }
    __device__ __forceinline__ void operator()(f32x4 (&acc)[2][2][4][2], const Unit& u, int wr, int wc, int fr, int fq) const {
        const int row0 = u.pm * BM + wr * 64 + fr, col0 = u.pn * BM + wc * 32 + 4 * fq;
        f32x4 gv[2][2];
#pragma unroll
        for (int bj = 0; bj < 2; ++bj)
#pragma unroll
            for (int n = 0; n < 2; ++n) gv[bj][n] = *(const f32x4*)(gate + col0 + bj * HALF + n * 16);
#pragma unroll
        for (int ai = 0; ai < 2; ++ai)
#pragma unroll
            for (int m = 0; m < 4; ++m) { const size_t off = (size_t)(row0 + ai * HALF + m * 16) * ldc + col0;
#pragma unroll
                for (int bj = 0; bj < 2; ++bj)
#pragma unroll
                    for (int n = 0; n < 2; ++n) { const f32x4 bs = *(const f32x4*)(base + off + bj * HALF + n * 16); *(f32x4*)(out + off + bj * HALF + n * 16) = bs + gv[bj][n] * acc[ai][bj][m][n]; }
                if (m & 1) asm volatile("" ::: "memory"); }
    }
};
struct EpiSwiglu {
    static constexpr bool PERM = true;
    bf16_t* O; int ldc;
    __device__ __forceinline__ bool keep(const Unit&) const { return false; }
    __device__ __forceinline__ void operator()(f32x4 (&acc)[2][2][4][2], const Unit& u, int wr, int wc, int fr, int fq) const {
        const int row0 = u.pm * BM + wr * 64 + fr, col0 = u.pn * HALF + wc * 32 + 8 * fq;
#pragma unroll
        for (int ai = 0; ai < 2; ++ai)
#pragma unroll
            for (int m = 0; m < 4; ++m) { float o[8];
#pragma unroll
                for (int n = 0; n < 2; ++n)
#pragma unroll
                    for (int e = 0; e < 4; ++e) { const float g = acc[ai][0][m][n][e], up = acc[ai][1][m][n][e]; o[4 * n + e] = g * __builtin_amdgcn_rcpf(1.f + exp_neg(g)) * up; }
                u32x4 w; w.x = cvt_pk_bf16(o[0], o[1]); w.y = cvt_pk_bf16(o[2], o[3]); w.z = cvt_pk_bf16(o[4], o[5]); w.w = cvt_pk_bf16(o[6], o[7]);
                *(u32x4*)(O + (size_t)(row0 + ai * HALF + m * 16) * ldc + col0) = w; }
    }
};

#ifndef CFG_ALIGN
#define CFG_ALIGN true
#endif
#ifndef CFG_SP2
#define CFG_SP2 true
#endif
template <class Epi, class Sched, bool ALIGN_EPI = CFG_ALIGN, bool SP2 = CFG_SP2>
__device__ __forceinline__ void gemm_phase(PG8_LAS unsigned char* lds, const Gemm g, const Sched& S, const Epi& E) {
    const int tid = threadIdx.x, wid = __builtin_amdgcn_readfirstlane(tid >> 6), lane = tid & 63, wr = wid >> 2, wc = wid & 3, fr = lane & 15, fq = lane >> 4;
    const int K = g.K, nt = K / BK;
    unsigned voffA[2], voffB[2];
#pragma unroll
    for (int i = 0; i < 2; ++i) { int R, C; stage_rc(tid * 16 + i * 8192, R, C); const int Rb = Epi::PERM ? ((R & ~31) + perm32(R & 31)) : R;
        voffA[i] = (unsigned)(R * g.lda + C) * 2u; voffB[i] = (unsigned)(Rb * g.ldb + C) * 2u; }
    const size_t kstep = (size_t)(BK * 2);
    const size_t hstepA = (size_t)HALF * g.lda * 2, hstepB = (size_t)HALF * g.ldb * 2;
    const unsigned ldsw = (unsigned)wid * 1024u;
    const int aoff = lds_byte(wr * 64 + fr, fq * 8), boff = lds_byte(wc * 32 + fr, fq * 8);
#define PG8_SA(b, h) (((b) * 2 + (h)) * HTB)
#define PG8_SB(b, h) ((4 + (b) * 2 + (h)) * HTB)
#ifndef CFG_AUXA
#define CFG_AUXA 0
#endif
#ifndef CFG_AUXB
#define CFG_AUXB 0
#endif
#define PG8_STAGE(bufoff, gbase, voff) do { _Pragma("unroll") for (int _i = 0; _i < 2; ++_i) { \
        if ((bufoff) >= 4 * HTB) __builtin_amdgcn_global_load_lds((const unsigned*)((const char*)(gbase) + (voff)[_i]), (PG8_LAS unsigned*)(lds + (bufoff) + ldsw + _i * 8192), 16, 0, CFG_AUXB); \
        else __builtin_amdgcn_global_load_lds((const unsigned*)((const char*)(gbase) + (voff)[_i]), (PG8_LAS unsigned*)(lds + (bufoff) + ldsw + _i * 8192), 16, 0, CFG_AUXA); } } while (0)
#define PG8_LDA(dst, b, h) do { _Pragma("unroll") for (int m = 0; m < 4; ++m) _Pragma("unroll") for (int k = 0; k < 2; ++k) dst[m][k] = *(const PG8_LAS bf16x8*)(lds + PG8_SA(b, h) + aoff + m * 2048 + k * 1024); } while (0)
#define PG8_LDB(dst, b, h) do { _Pragma("unroll") for (int n = 0; n < 2; ++n) _Pragma("unroll") for (int k = 0; k < 2; ++k) dst[n][k] = *(const PG8_LAS bf16x8*)(lds + PG8_SB(b, h) + boff + n * 2048 + k * 1024); } while (0)
#define PG8_MMA(ai, bj, At, Bt) do { __builtin_amdgcn_s_setprio(1); _Pragma("unroll") for (int m = 0; m < 4; ++m) _Pragma("unroll") for (int n = 0; n < 2; ++n) _Pragma("unroll") for (int k = 0; k < 2; ++k) \
        acc[ai][bj][m][n] = __builtin_amdgcn_mfma_f32_16x16x32_bf16(Bt[n][k], At[m][k], acc[ai][bj][m][n], 0, 0, 0); __builtin_amdgcn_s_setprio(0); } while (0)
#ifndef CFG_MMA2
#define CFG_MMA2 0
#endif
#define PG8_MMA2(ai, At, B0, B1) do { __builtin_amdgcn_s_setprio(1); \
    if (CFG_MMA2 == 1) { _Pragma("unroll") for (int k = 0; k < 2; ++k) _Pragma("unroll") for (int m = 0; m < 4; ++m) { \
        acc[ai][0][m][0] = __builtin_amdgcn_mfma_f32_16x16x32_bf16(B0[0][k], At[m][k], acc[ai][0][m][0], 0, 0, 0); acc[ai][0][m][1] = __builtin_amdgcn_mfma_f32_16x16x32_bf16(B0[1][k], At[m][k], acc[ai][0][m][1], 0, 0, 0); \
        acc[ai][1][m][0] = __builtin_amdgcn_mfma_f32_16x16x32_bf16(B1[0][k], At[m][k], acc[ai][1][m][0], 0, 0, 0); acc[ai][1][m][1] = __builtin_amdgcn_mfma_f32_16x16x32_bf16(B1[1][k], At[m][k], acc[ai][1][m][1], 0, 0, 0); } } \
    else { _Pragma("unroll") for (int k = 0; k < 2; ++k) _Pragma("unroll") for (int n = 0; n < 2; ++n) { \
        _Pragma("unroll") for (int m = 0; m < 4; ++m) acc[ai][0][m][n] = __builtin_amdgcn_mfma_f32_16x16x32_bf16(B0[n][k], At[m][k], acc[ai][0][m][n], 0, 0, 0); \
        _Pragma("unroll") for (int m = 0; m < 4; ++m) acc[ai][1][m][n] = __builtin_amdgcn_mfma_f32_16x16x32_bf16(B1[n][k], At[m][k], acc[ai][1][m][n], 0, 0, 0); } } \
    __builtin_amdgcn_s_setprio(0); } while (0)
#define PG8_WAIT_V(n) asm volatile("s_waitcnt vmcnt(" #n ")" ::: "memory")
#define PG8_WAIT_L(n) asm volatile("s_waitcnt lgkmcnt(" #n ")" ::: "memory")
#define PG8_BAR __builtin_amdgcn_s_barrier()
#define PG8_SCHED __builtin_amdgcn_sched_barrier(0)
    Unit cur, nxt; int ui = 0;
    if (!S.next(0, cur)) return;
    f32x4 acc[2][2][4][2];
#pragma unroll
    for (int a = 0; a < 2; ++a)
#pragma unroll
        for (int b = 0; b < 2; ++b)
#pragma unroll
            for (int m = 0; m < 4; ++m)
#pragma unroll
                for (int n = 0; n < 2; ++n) acc[a][b][m][n] = (f32x4){0.f, 0.f, 0.f, 0.f};
    bf16x8 At[4][2], B0[2][2], B1[2][2];
    const char* cA = cur.a; const char* cB = cur.b;
    if constexpr (SP2) {
        PG8_STAGE(PG8_SB(0, 0), cB, voffB); PG8_STAGE(PG8_SB(0, 1), cB + hstepB, voffB); PG8_STAGE(PG8_SA(0, 0), cA, voffA); PG8_STAGE(PG8_SA(0, 1), cA + hstepA, voffA);
        if (wr == 1) PG8_BAR;
        PG8_WAIT_V(2); PG8_BAR;
        PG8_STAGE(PG8_SB(1, 0), cB + kstep, voffB); PG8_STAGE(PG8_SA(1, 0), cA + kstep, voffA); PG8_STAGE(PG8_SB(1, 1), cB + hstepB + kstep, voffB);
        PG8_WAIT_V(6); PG8_BAR;
    } else {
        PG8_STAGE(PG8_SB(0, 0), cB, voffB); PG8_STAGE(PG8_SA(0, 0), cA, voffA); PG8_STAGE(PG8_SB(0, 1), cB + hstepB, voffB); PG8_STAGE(PG8_SA(0, 1), cA + hstepA, voffA);
        if (wr == 1) PG8_BAR;
        PG8_WAIT_V(4); PG8_BAR;
        PG8_STAGE(PG8_SB(1, 0), cB + kstep, voffB); PG8_STAGE(PG8_SA(1, 0), cA + kstep, voffA); PG8_STAGE(PG8_SB(1, 1), cB + hstepB + kstep, voffB);
        PG8_WAIT_V(6); PG8_BAR;
    }
    for (;;) {
        const bool has_next = S.next(ui + 1, nxt);
        const char* nA = has_next ? nxt.a : cA; const char* nB = has_next ? nxt.b : cB;
        for (int t = 0; t < nt; t += 2) {
            const bool last = (t == nt - 2);
            const char* a1 = cA + (size_t)(t + 1) * kstep;
            const char* a2 = last ? nA : cA + (size_t)(t + 2) * kstep; const char* b2 = last ? nB : cB + (size_t)(t + 2) * kstep;
            const char* a3 = a2 + kstep; const char* b3 = b2 + kstep;
            if constexpr (SP2) {
            PG8_LDB(B0, 0, 0); PG8_LDB(B1, 0, 1); PG8_SCHED; PG8_LDA(At, 0, 0); PG8_STAGE(PG8_SA(1, 1), a1 + hstepA, voffA);
            PG8_WAIT_V(8); PG8_WAIT_L(0); PG8_BAR; if (CFG_MMA2) PG8_MMA2(0, At, B0, B1); else { PG8_MMA(0, 0, At, B0); PG8_MMA(0, 1, At, B1); } PG8_BAR; PG8_SCHED;
            PG8_LDA(At, 0, 1); PG8_STAGE(PG8_SB(0, 0), b2, voffB); PG8_STAGE(PG8_SB(0, 1), b2 + hstepB, voffB); PG8_STAGE(PG8_SA(0, 0), a2, voffA);
            PG8_WAIT_V(8); PG8_WAIT_L(0); PG8_BAR; if (CFG_MMA2) PG8_MMA2(1, At, B0, B1); else { PG8_MMA(1, 0, At, B0); PG8_MMA(1, 1, At, B1); } PG8_BAR; PG8_SCHED;
            PG8_LDB(B0, 1, 0); PG8_LDB(B1, 1, 1); PG8_SCHED; PG8_LDA(At, 1, 0); PG8_STAGE(PG8_SA(0, 1), a2 + hstepA, voffA);
            PG8_WAIT_V(8); PG8_WAIT_L(0); PG8_BAR; if (CFG_MMA2) PG8_MMA2(0, At, B0, B1); else { PG8_MMA(0, 0, At, B0); PG8_MMA(0, 1, At, B1); } PG8_BAR; PG8_SCHED;
            PG8_LDA(At, 1, 1); PG8_STAGE(PG8_SB(1, 0), b3, voffB); PG8_STAGE(PG8_SB(1, 1), b3 + hstepB, voffB); PG8_STAGE(PG8_SA(1, 0), a3, voffA);
            PG8_WAIT_V(8); PG8_WAIT_L(0); PG8_BAR; if (CFG_MMA2) PG8_MMA2(1, At, B0, B1); else { PG8_MMA(1, 0, At, B0); PG8_MMA(1, 1, At, B1); } PG8_BAR; PG8_SCHED;
            } else {
            PG8_LDB(B0, 0, 0); PG8_SCHED; PG8_LDA(At, 0, 0); PG8_STAGE(PG8_SA(1, 1), a1 + hstepA, voffA);
            PG8_WAIT_L(8); PG8_BAR; PG8_WAIT_L(0); PG8_MMA(0, 0, At, B0); PG8_BAR; PG8_SCHED;
            PG8_LDB(B1, 0, 1); PG8_STAGE(PG8_SB(0, 0), b2, voffB);
            PG8_BAR; PG8_WAIT_L(0); PG8_MMA(0, 1, At, B1); PG8_BAR;
            PG8_LDA(At, 0, 1); PG8_STAGE(PG8_SA(0, 0), a2, voffA);
            PG8_BAR; PG8_WAIT_L(0); PG8_MMA(1, 0, At, B0); PG8_BAR; PG8_SCHED;
            PG8_STAGE(PG8_SB(0, 1), b2 + hstepB, voffB);
            PG8_WAIT_V(6); PG8_BAR; PG8_MMA(1, 1, At, B1); PG8_BAR;
            PG8_LDB(B0, 1, 0); PG8_SCHED; PG8_LDA(At, 1, 0); PG8_STAGE(PG8_SA(0, 1), a2 + hstepA, voffA);
            PG8_WAIT_L(8); PG8_BAR; PG8_WAIT_L(0); PG8_MMA(0, 0, At, B0); PG8_BAR; PG8_SCHED;
            PG8_LDB(B1, 1, 1); PG8_STAGE(PG8_SB(1, 0), b3, voffB);
            PG8_BAR; PG8_WAIT_L(0); PG8_MMA(0, 1, At, B1); PG8_BAR;
            PG8_LDA(At, 1, 1); PG8_STAGE(PG8_SA(1, 0), a3, voffA);
            PG8_BAR; PG8_WAIT_L(0); PG8_MMA(1, 0, At, B0); PG8_BAR; PG8_SCHED;
            PG8_STAGE(PG8_SB(1, 1), b3 + hstepB, voffB);
            PG8_WAIT_V(6); PG8_BAR; PG8_MMA(1, 1, At, B1); PG8_BAR;
            }
        }
        if constexpr (ALIGN_EPI) { if (wr == 0) PG8_BAR; }
        E(acc, cur, wr, wc, fr, fq);
        if (!has_next) break;
        if (!E.keep(cur)) {
#pragma unroll
        for (int a = 0; a < 2; ++a)
#pragma unroll
            for (int b = 0; b < 2; ++b)
#pragma unroll
                for (int m = 0; m < 4; ++m)
#pragma unroll
                    for (int n = 0; n < 2; ++n) acc[a][b][m][n] = (f32x4){0.f, 0.f, 0.f, 0.f};
        }
        cur = nxt; cA = nA; cB = nB; ++ui;
        if constexpr (ALIGN_EPI) { if (wr == 1) PG8_BAR; }
    }
    PG8_WAIT_V(0);
    if constexpr (!ALIGN_EPI) { if (wr == 0) PG8_BAR; }
    PG8_BAR;
#undef PG8_SA
#undef PG8_SB
#undef PG8_STAGE
#undef PG8_LDA
#undef PG8_LDB
#undef PG8_MMA
#undef PG8_MMA2
#undef PG8_WAIT_V
#undef PG8_WAIT_L
#undef PG8_BAR
#undef PG8_SCHED
}
}

constexpr int NWAVES = 8;
constexpr int N_LAUNCHES = MK_N_LAUNCHES;
constexpr int PER_PHASE = 11;

constexpr int S = 8192, D = 4096, CW = 2048, PW = 2048, PGRP = 512, FF = 11008, INC = 16384, NMODV = 6 * D;
constexpr float EPS = 1e-6f;
constexpr int KSPLIT = 8;

constexpr size_t MiB = 1u << 20;
constexpr size_t WS_CTL = 0, CTL_ZERO_BYTES = 64 * 1024;
constexpr size_t WS_MODP = 1 * MiB;
constexpr size_t WS_MODF = WS_MODP + (size_t)KSPLIT * NMODV * 4;
constexpr size_t WS_WIN = 2 * MiB;
constexpr size_t WS_WCP = 130 * MiB;
constexpr size_t WS_WPG = 162 * MiB;
constexpr size_t WS_WO = 164 * MiB;
constexpr size_t WS_WGU = 196 * MiB;
constexpr size_t WS_WD = 368 * MiB;
constexpr size_t WS_H = 454 * MiB;
constexpr size_t WS_PROJ = 518 * MiB;
constexpr size_t WS_AM = 774 * MiB;
constexpr size_t WS_POOLED = 838 * MiB;
constexpr size_t WS_MERGED = 870 * MiB;
constexpr size_t WS_X1 = 934 * MiB;
constexpr size_t WS_H2 = 1062 * MiB;
constexpr size_t WS_ACT = 1126 * MiB;
constexpr size_t WS_END = 1298 * MiB;
static_assert(WS_MODF + NMODV * 4 <= WS_WIN && WS_ACT + (size_t)S * FF * 2 <= WS_END, "d_ws map");
constexpr int CW_QWD = 64;
constexpr int CW_BAR = 1024;
constexpr int RING_OFF = 0, RING_BYTES = 131072;
constexpr int LDSCTL_OFF = RING_BYTES + 8192, MISC_OFF = LDSCTL_OFF;
constexpr int LDS_BYTES = 147456;

#define GAS __attribute__((address_space(1)))
#define LAS __attribute__((address_space(3)))
typedef unsigned short bf16;
typedef unsigned v4u __attribute__((ext_vector_type(4)));
typedef float f32x4 __attribute__((ext_vector_type(4)));
typedef GAS unsigned gu32;
#define RLX_AGENT __ATOMIC_RELAXED, __HIP_MEMORY_SCOPE_AGENT
#define LDS_WAIT() asm volatile("s_waitcnt lgkmcnt(0)" ::: "memory")
__device__ __forceinline__ unsigned pk2(float lo, float hi) { return pg8::cvt_pk_bf16(lo, hi); }
__device__ __forceinline__ void unpack8(const v4u w, float (&f)[8]) {
#pragma unroll
    for (int e = 0; e < 4; ++e) { f[2 * e] = pg8::bf_lo(w[e]); f[2 * e + 1] = pg8::bf_hi(w[e]); } }
__device__ __forceinline__ v4u pack8(const float (&f)[8]) { v4u w; w.x = pk2(f[0], f[1]); w.y = pk2(f[2], f[3]); w.z = pk2(f[4], f[5]); w.w = pk2(f[6], f[7]); return w; }

#define XB_TMO      128
#define XB_XCNT(j)  (256  + 64 * (j))
#define XB_XSUB(j)  (1280 + 64 * (j))
#define XB_XGEN(j)  (2304 + 64 * (j))
#define XB_TOP      3328
#define XB_TOPGEN   3392
#define XCD_BAR_WORDS 3456
#define XB_SPIN_CAP (1u << 18)
static_assert((CW_BAR + XCD_BAR_WORDS) * 4 <= (int)CTL_ZERO_BYTES, "barrier words inside the memset region");

__device__ __forceinline__ unsigned xb_ld(unsigned* p)              { return __hip_atomic_load(p, __ATOMIC_RELAXED, __HIP_MEMORY_SCOPE_AGENT); }
__device__ __forceinline__ unsigned xb_add(unsigned* p, unsigned v) { return __hip_atomic_fetch_add(p, v, __ATOMIC_RELAXED, __HIP_MEMORY_SCOPE_AGENT); }
__device__ __forceinline__ unsigned xb_xcc_id() { return (unsigned)__builtin_amdgcn_s_getreg((3 << 11) | 20) & 0xFu; }
#define XB_SPIN(cond, bar) do { unsigned _sp = 0; while (cond) { __builtin_amdgcn_s_sleep(1); \
    if ((++_sp & 255u) == 0u) { if (xb_ld(&(bar)[XB_TMO])) break; if (_sp > XB_SPIN_CAP) { atomicAdd(&(bar)[XB_TMO], 1u); break; } } } } while (0)

struct XcdBarrier {
    unsigned* bar; unsigned x;
    volatile LAS unsigned* st;
};
__device__ __forceinline__ XcdBarrier xcd_barrier_post(unsigned* bar, volatile LAS unsigned* st) {
    XcdBarrier b; b.bar = bar; b.x = xb_xcc_id(); b.st = st;
    if (threadIdx.x == 0) (void)xb_add(&bar[XB_XCNT(b.x)], 1u);
    return b;
}
__device__ __forceinline__ void xcd_barrier_complete(unsigned* bar, unsigned x, unsigned& nloc, unsigned& nx) {
    const unsigned G = gridDim.x * gridDim.y * gridDim.z;
    unsigned sum, cnt, mine, sp = 0u;
    for (;;) {
        sum = 0u; cnt = 0u; mine = 0u;
#pragma unroll
        for (unsigned j = 0; j < 16; ++j) { const unsigned c = xb_ld(&bar[XB_XCNT(j)]); sum += c; cnt += (c > 0u) ? 1u : 0u; mine = (j == x) ? c : mine; }
        if (sum == G) break;
        __builtin_amdgcn_s_sleep(1);
        if ((++sp & 255u) == 0u) { if (xb_ld(&bar[XB_TMO])) break; if (sp > XB_SPIN_CAP) { atomicAdd(&bar[XB_TMO], 1u); break; } }
    }
    nloc = mine > 0u ? mine : 1u; nx = cnt > 0u ? cnt : 1u;
}
__device__ __forceinline__ void xcd_barrier(const XcdBarrier& b) {
    asm volatile("s_waitcnt vmcnt(0)" ::: "memory");
    __syncthreads();
    if (threadIdx.x == 0) {
        unsigned* bar = b.bar;
        __builtin_amdgcn_s_waitcnt(0);
        unsigned nloc = b.st[0], nx = b.st[1];
        if (nloc == 0u) { xcd_barrier_complete(bar, b.x, nloc, nx); b.st[0] = nloc; b.st[1] = nx; }
        const unsigned old = xb_add(&bar[XB_XSUB(b.x)], 1u);
        const unsigned gen = old / nloc;
        if (old + 1u == (gen + 1u) * nloc) {
            __builtin_amdgcn_fence(__ATOMIC_RELEASE, "agent");
            asm volatile("s_waitcnt vmcnt(0)" ::: "memory");
            const unsigned og = xb_add(&bar[XB_TOP], 1u);
            const unsigned tg = og / nx;
            if (og + 1u == (tg + 1u) * nx) xb_add(&bar[XB_TOPGEN], 1u);
            else XB_SPIN(xb_ld(&bar[XB_TOPGEN]) == tg, bar);
            __builtin_amdgcn_fence(__ATOMIC_ACQUIRE, "agent");
            xb_add(&bar[XB_XGEN(b.x)], 1u);
            asm volatile("s_waitcnt vmcnt(0)" ::: "memory");
        } else {
            XB_SPIN(xb_ld(&bar[XB_XGEN(b.x)]) == gen, bar);
            __builtin_amdgcn_fence(__ATOMIC_ACQUIRE, "agent");
            asm volatile("s_waitcnt vmcnt(0)" ::: "memory");
        }
    }
    __syncthreads();
}

struct Frame {
    LAS unsigned char* lds;
    volatile LAS unsigned* MISC;
    gu32* ctl;
    int tid, lane, wave;
    int vcu, G;
    const float *x, *cvec, *w_ada, *b_ada, *g1, *w_in, *gbias, *conv_w, *w_conv_out, *w_pool_group, *pool_scale, *w_pool_out, *w_o, *g2, *w_gate_up, *w_down, *gf;
    float* out;
    float *MODP, *MODF, *X1;
    bf16 *Win_t, *Wcp_t, *Wpg_t, *Wo_t, *Wgu_t, *Wd_t, *H, *PROJ, *AM, *POOLED, *MERGED, *H2, *ACT;
};

__device__ __forceinline__ float wave_sum(float v) {
#pragma unroll
    for (int o = 1; o < 64; o <<= 1) v += __shfl_xor(v, o);
    return v;
}

__device__ __forceinline__ void tr_item(const float* W, int N, int k0, int n0, bf16* dst, size_t dpitch, LAS float* scr, int lane) {
    const GAS f32x4* src = (const GAS f32x4*)(W + (size_t)(k0 + (lane >> 4)) * N + n0 + 4 * (lane & 15));
    f32x4 v[16];
#pragma unroll
    for (int i = 0; i < 16; ++i) v[i] = __builtin_nontemporal_load(src + (size_t)i * N);
#pragma unroll
    for (int i = 0; i < 16; ++i) { LAS float* p = scr + (4 * i + (lane >> 4)) * 65 + 4 * (lane & 15); p[0] = v[i].x; p[1] = v[i].y; p[2] = v[i].z; p[3] = v[i].w; }
    LDS_WAIT(); asm volatile("" ::: "memory");
    const int c = lane >> 3;
#pragma unroll
    for (int j = 0; j < 8; ++j) { const int n = (lane & 7) + 8 * j; const LAS float* s = scr + (8 * c) * 65 + n;
        v4u o; o.x = pk2(s[0 * 65], s[1 * 65]); o.y = pk2(s[2 * 65], s[3 * 65]); o.z = pk2(s[4 * 65], s[5 * 65]); o.w = pk2(s[6 * 65], s[7 * 65]);
        *(GAS v4u*)(dst + (size_t)n * dpitch + 8 * c) = o; }
    LDS_WAIT(); asm volatile("" ::: "memory");
}

__device__ __forceinline__ void p0_prologue(Frame& F) {
    {
        LAS float* cs = (LAS float*)(F.lds);
        LAS float* red = (LAS float*)(F.lds + 16384);
        for (int i = F.tid; i < D; i += NWAVES * 64) { const float c = F.cvec[i]; cs[i] = c / (1.f + __expf(-c)); }
        __syncthreads();
        for (int it = blockIdx.x; it < 96 * KSPLIT; it += F.G) {
            const int cch = it % 96, kr = it / 96, rbase = kr * 512 + F.wave * 64;
            const float* wp = F.w_ada + (size_t)rbase * NMODV + cch * 256 + F.lane * 4;
            f32x4 a = (f32x4){0.f, 0.f, 0.f, 0.f};
#pragma unroll 1
            for (int r0 = 0; r0 < 64; r0 += 16) { f32x4 v[16];
#pragma unroll
                for (int q = 0; q < 16; ++q) v[q] = __builtin_nontemporal_load((const GAS f32x4*)(wp + (size_t)(r0 + q) * NMODV));
#pragma unroll
                for (int q = 0; q < 16; ++q) a += v[q] * cs[rbase + r0 + q]; }
            *(LAS f32x4*)(red + F.wave * 256 + F.lane * 4) = a;
            __syncthreads();
            if (F.tid < 256) { float s = 0.f;
#pragma unroll
                for (int w = 0; w < 8; ++w) s += red[w * 256 + F.tid];
                F.MODP[(size_t)kr * NMODV + cch * 256 + F.tid] = s; }
            __syncthreads();
        }
    }
    LAS float* scr = (LAS float*)(F.lds + RING_OFF + F.wave * 16640);
    const int gw = F.vcu * NWAVES + F.wave, NGW = F.G * NWAVES;
    constexpr int I_IN = (D / 64) * (INC / 64), I_CV = (CW / 64) * (D / 64), I_PG = 4 * (PGRP / 64) * (PGRP / 64), I_O = (D / 64) * (D / 64), I_GU = (D / 64) * (2 * FF / 64), I_DN = (FF / 64) * (D / 64);
    constexpr int NITEMS = I_IN + 2 * I_CV + I_PG + I_O + I_GU;
    for (int it = gw; it < NITEMS; it += NGW) {
        int r = it;
        if (r < I_IN) { const int nb = INC / 64, kb = r / nb, n0 = (r % nb) * 64; tr_item(F.w_in, INC, kb * 64, n0, F.Win_t + (size_t)n0 * D + kb * 64, D, scr, F.lane); continue; } r -= I_IN;
        if (r < I_CV) { const int nb = D / 64, kb = r / nb, n0 = (r % nb) * 64; tr_item(F.w_conv_out, D, kb * 64, n0, F.Wcp_t + (size_t)n0 * D + kb * 64, D, scr, F.lane); continue; } r -= I_CV;
        if (r < I_CV) { const int nb = D / 64, kb = r / nb, n0 = (r % nb) * 64; tr_item(F.w_pool_out, D, kb * 64, n0, F.Wcp_t + (size_t)n0 * D + CW + kb * 64, D, scr, F.lane); continue; } r -= I_CV;
        if (r < I_PG) { const int g = r / 64, q = r % 64, kb = q / 8, n0 = (q % 8) * 64; tr_item(F.w_pool_group + (size_t)g * PGRP * PGRP, PGRP, kb * 64, n0, F.Wpg_t + (size_t)(g * PGRP + n0) * PGRP + kb * 64, PGRP, scr, F.lane); continue; } r -= I_PG;
        if (r < I_O) { const int nb = D / 64, kb = r / nb, n0 = (r % nb) * 64; tr_item(F.w_o, D, kb * 64, n0, F.Wo_t + (size_t)n0 * D + kb * 64, D, scr, F.lane); continue; } r -= I_O;
        if (r < I_GU) { const int nb = 2 * FF / 64, kb = r / nb, n0 = (r % nb) * 64; const int isup = n0 >= FF, nn = isup ? n0 - FF : n0, drow = (nn >> 7) * 256 + isup * 128 + (nn & 127);
            tr_item(F.w_gate_up, 2 * FF, kb * 64, n0, F.Wgu_t + (size_t)drow * D + kb * 64, D, scr, F.lane); }
    }
}
__device__ __forceinline__ void tr_load(const float* W, int N, int k0, int n0, int lane, f32x4 (&v)[16]) {
    const GAS f32x4* src = (const GAS f32x4*)(W + (size_t)(k0 + (lane >> 4)) * N + n0 + 4 * (lane & 15));
#pragma unroll
    for (int i = 0; i < 16; ++i) v[i] = __builtin_nontemporal_load(src + (size_t)i * N);
}
__device__ __forceinline__ void tr_emit(const f32x4 (&v)[16], bf16* dst, size_t dpitch, LAS float* scr, int lane) {
#pragma unroll
    for (int i = 0; i < 16; ++i) { LAS float* p = scr + (4 * i + (lane >> 4)) * 65 + 4 * (lane & 15); p[0] = v[i].x; p[1] = v[i].y; p[2] = v[i].z; p[3] = v[i].w; }
    LDS_WAIT(); asm volatile("" ::: "memory");
    const int c = lane >> 3;
#pragma unroll
    for (int j = 0; j < 8; ++j) { const int n = (lane & 7) + 8 * j; const LAS float* s = scr + (8 * c) * 65 + n;
        v4u o; o.x = pk2(s[0 * 65], s[1 * 65]); o.y = pk2(s[2 * 65], s[3 * 65]); o.z = pk2(s[4 * 65], s[5 * 65]); o.w = pk2(s[6 * 65], s[7 * 65]);
        *(GAS v4u*)(dst + (size_t)n * dpitch + 8 * c) = o; }
    LDS_WAIT(); asm volatile("" ::: "memory");
}
__device__ __forceinline__ void p8_tail_convert_wd(Frame& F) {
    constexpr int I_DN = (FF / 64) * (D / 64), NB = D / 64;
    const int nunits = (S / 256) * (2 * FF / 256), rounds = (nunits + F.G - 1) / F.G, nshort = rounds * F.G - nunits;
    int w0, nw;
    if (nshort > 0) { if ((int)blockIdx.x < F.G - nshort) return; w0 = ((int)blockIdx.x - (F.G - nshort)) * NWAVES + F.wave; nw = nshort * NWAVES; }
    else { w0 = (int)blockIdx.x * NWAVES + F.wave; nw = F.G * NWAVES; }
    LAS float* scr = (LAS float*)(F.lds + RING_OFF + F.wave * 16640);
    f32x4 va[16], vb[16];
    int ia = w0;
    if (ia < I_DN) tr_load(F.w_down, D, (ia / NB) * 64, (ia % NB) * 64, F.lane, va);
    while (ia < I_DN) {
        const int ib = ia + nw;
        if (ib < I_DN) tr_load(F.w_down, D, (ib / NB) * 64, (ib % NB) * 64, F.lane, vb);
        tr_emit(va, F.Wd_t + (size_t)((ia % NB) * 64) * FF + (ia / NB) * 64, FF, scr, F.lane);
        if (ib >= I_DN) break;
        ia = ib + nw;
        if (ia < I_DN) tr_load(F.w_down, D, (ia / NB) * 64, (ia % NB) * 64, F.lane, va);
        tr_emit(vb, F.Wd_t + (size_t)((ib % NB) * 64) * FF + (ib / NB) * 64, FF, scr, F.lane);
    }
}

__device__ __forceinline__ void norm_rows_bf16(Frame& F, const float* src, bf16* dst, const LAS float* Amul, const LAS float* Badd) {
    const int gw = F.vcu * NWAVES + F.wave, NGW = F.G * NWAVES;
    for (int r = gw; r < S; r += NGW) {
        const GAS f32x4* xr = (const GAS f32x4*)(src + (size_t)r * D) + F.lane;
        f32x4 v[16]; float s = 0.f;
#pragma unroll
        for (int j = 0; j < 16; ++j) { v[j] = __builtin_nontemporal_load(xr + 64 * j); s += (v[j].x * v[j].x + v[j].y * v[j].y) + (v[j].z * v[j].z + v[j].w * v[j].w); }
        const float rstd = 1.f / sqrtf(wave_sum(s) * (1.f / D) + EPS);
        GAS unsigned long long* o8 = (GAS unsigned long long*)(dst + (size_t)r * D) + F.lane;
#pragma unroll
        for (int j = 0; j < 16; ++j) { const f32x4 a = *(const LAS f32x4*)(Amul + 4 * F.lane + 256 * j), b = *(const LAS f32x4*)(Badd + 4 * F.lane + 256 * j);
            const f32x4 o = v[j] * rstd * a + b;
            o8[64 * j] = (unsigned long long)pk2(o.x, o.y) | ((unsigned long long)pk2(o.z, o.w) << 32); }
    }
}

__device__ __forceinline__ void p1_norm1(Frame& F) {
    LAS float* Amul = (LAS float*)(F.lds); LAS float* Badd = (LAS float*)(F.lds + 16384);
    for (int d = F.tid; d < D; d += NWAVES * 64) { float sh = F.b_ada[d], sc = F.b_ada[D + d];
#pragma unroll
        for (int p = 0; p < KSPLIT; ++p) { sh += F.MODP[(size_t)p * NMODV + d]; sc += F.MODP[(size_t)p * NMODV + D + d]; }
        Amul[d] = F.g1[d] * (1.f + sc); Badd[d] = sh; }
    { const int gt = blockIdx.x * (NWAVES * 64) + F.tid;
      for (int j = gt; j < NMODV; j += F.G * NWAVES * 64) { float s = F.b_ada[j];
#pragma unroll
          for (int p = 0; p < KSPLIT; ++p) s += F.MODP[(size_t)p * NMODV + j];
          F.MODF[j] = s; } }
    __syncthreads();
    norm_rows_bf16(F, F.x, F.H, Amul, Badd);
}
__device__ __forceinline__ void p7_norm2(Frame& F) {
    LAS float* Amul = (LAS float*)(F.lds); LAS float* Badd = (LAS float*)(F.lds + 16384);
    for (int d = F.tid; d < D; d += NWAVES * 64) { Amul[d] = F.g2[d] * (1.f + F.MODF[4 * D + d]); Badd[d] = F.MODF[3 * D + d]; }
    __syncthreads();
    norm_rows_bf16(F, F.X1, F.H2, Amul, Badd);
}
__device__ __forceinline__ void p10_final_norm(Frame& F) {
    const int gw = F.vcu * NWAVES + F.wave, NGW = F.G * NWAVES;
    for (int r = gw; r < S; r += NGW) {
        GAS f32x4* xr = (GAS f32x4*)(F.out + (size_t)r * D) + F.lane;
        f32x4 v[16]; float s = 0.f;
#pragma unroll
        for (int j = 0; j < 16; ++j) { v[j] = xr[64 * j]; s += (v[j].x * v[j].x + v[j].y * v[j].y) + (v[j].z * v[j].z + v[j].w * v[j].w); }
        const float rstd = 1.f / sqrtf(wave_sum(s) * (1.f / D) + EPS);
#pragma unroll
        for (int j = 0; j < 16; ++j) { const f32x4 g = *(const GAS f32x4*)(F.gf + 4 * F.lane + 256 * j); xr[64 * j] = v[j] * rstd * g; }
    }
}

__device__ __forceinline__ void p3_conv_pool(Frame& F) {
    const int gt = blockIdx.x * (NWAVES * 64) + F.tid;
    for (int item = gt; item < (S / 16) * (CW / 8); item += F.G * NWAVES * 64) {
        const int c = (item & 255) * 8, t0 = (item >> 8) * 16;
        {
            float w0[8], w1[8], w2[8];
#pragma unroll
            for (int h = 0; h < 2; ++h) { const f32x4 a = *(const GAS f32x4*)(F.conv_w + c + 4 * h), b = *(const GAS f32x4*)(F.conv_w + CW + c + 4 * h), d = *(const GAS f32x4*)(F.conv_w + 2 * CW + c + 4 * h);
#pragma unroll
                for (int e = 0; e < 4; ++e) { w0[4 * h + e] = a[e]; w1[4 * h + e] = b[e]; w2[4 * h + e] = d[e]; } }
            float u1[8], u2[8];
#pragma unroll
            for (int e = 0; e < 8; ++e) { u1[e] = 0.f; u2[e] = 0.f; }
            if (t0 >= 2) {
                float a[8], b[8];
                unpack8(__builtin_nontemporal_load((const GAS v4u*)(F.PROJ + (size_t)(t0 - 2) * INC + CW + c)), a); unpack8(__builtin_nontemporal_load((const GAS v4u*)(F.PROJ + (size_t)(t0 - 2) * INC + 2 * CW + c)), b);
#pragma unroll
                for (int e = 0; e < 8; ++e) u2[e] = a[e] * b[e];
                unpack8(__builtin_nontemporal_load((const GAS v4u*)(F.PROJ + (size_t)(t0 - 1) * INC + CW + c)), a); unpack8(__builtin_nontemporal_load((const GAS v4u*)(F.PROJ + (size_t)(t0 - 1) * INC + 2 * CW + c)), b);
#pragma unroll
                for (int e = 0; e < 8; ++e) u1[e] = a[e] * b[e];
            }
#pragma unroll 4
            for (int i = 0; i < 16; ++i) { const bf16* rp = F.PROJ + (size_t)(t0 + i) * INC + c;
                float gb[8], gc[8], vv[8], o[8];
                unpack8(__builtin_nontemporal_load((const GAS v4u*)(rp)), gb); unpack8(__builtin_nontemporal_load((const GAS v4u*)(rp + CW)), gc); unpack8(__builtin_nontemporal_load((const GAS v4u*)(rp + 2 * CW)), vv);
#pragma unroll
                for (int e = 0; e < 8; ++e) { const float u0 = gc[e] * vv[e]; o[e] = gb[e] * (w0[e] * u2[e] + w1[e] * u1[e] + w2[e] * u0); u2[e] = u1[e]; u1[e] = u0; }
                *(GAS v4u*)(F.AM + (size_t)(t0 + i) * D + c) = pack8(o); }
        }
        {
            const int W = 2 << (c >> 9);
            const bf16* pp = F.PROJ + 3 * CW + c;
            float sum[8];
#pragma unroll
            for (int e = 0; e < 8; ++e) sum[e] = 0.f;
            for (int j = (t0 - W + 1 > 0 ? t0 - W + 1 : 0); j < t0; ++j) { float a[8]; unpack8(__builtin_nontemporal_load((const GAS v4u*)(pp + (size_t)j * INC)), a);
#pragma unroll
                for (int e = 0; e < 8; ++e) sum[e] += a[e]; }
#pragma unroll 4
            for (int i = 0; i < 16; ++i) { const int t = t0 + i; float pn[8], po[8], o[8];
                unpack8(__builtin_nontemporal_load((const GAS v4u*)(pp + (size_t)t * INC)), pn);
                const int told = t - W + 1;
                if (told >= 0) unpack8(__builtin_nontemporal_load((const GAS v4u*)(pp + (size_t)told * INC)), po); else {
#pragma unroll
                    for (int e = 0; e < 8; ++e) po[e] = 0.f; }
                const float inv = 1.f / (float)(t + 1 < W ? t + 1 : W);
#pragma unroll
                for (int e = 0; e < 8; ++e) { sum[e] += pn[e]; o[e] = sum[e] * inv - pn[e]; sum[e] -= po[e]; }
                *(GAS v4u*)(F.POOLED + (size_t)t * PW + c) = pack8(o); }
        }
    }
}

#ifndef WGM_P2
#define WGM_P2 4
#endif
#ifndef WGM_P4
#define WGM_P4 4
#endif
#ifndef WGM_P5
#define WGM_P5 4
#endif
#ifndef WGM_P6
#define WGM_P6 4
#endif
#ifndef WGM_P8
#define WGM_P8 4
#endif
#ifndef WGM_P9
#define WGM_P9 4
#endif
struct Args { const float* in[17]; float* out; unsigned char* ws; int ph_lo, ph_hi; };
__global__ void __launch_bounds__(NWAVES * 64, 2) mk_fwd(Args args) {
    extern __shared__ __attribute__((aligned(16))) unsigned char lds[];
    Frame F;
    F.lds = (LAS unsigned char*)lds;
    F.MISC = (volatile LAS unsigned*)(F.lds + MISC_OFF);
    F.tid = threadIdx.x; F.lane = F.tid & 63; F.wave = __builtin_amdgcn_readfirstlane(F.tid >> 6);
    F.G = gridDim.x; { const int bx = blockIdx.x; F.vcu = (F.G % 8 == 0) ? (bx % 8) * (F.G / 8) + bx / 8 : bx; }
    unsigned char* ws = args.ws;
    F.ctl = (gu32*)(ws + WS_CTL);
    F.x = args.in[0]; F.cvec = args.in[1]; F.w_ada = args.in[2]; F.b_ada = args.in[3]; F.g1 = args.in[4]; F.w_in = args.in[5]; F.gbias = args.in[6]; F.conv_w = args.in[7];
    F.w_conv_out = args.in[8]; F.w_pool_group = args.in[9]; F.pool_scale = args.in[10]; F.w_pool_out = args.in[11]; F.w_o = args.in[12]; F.g2 = args.in[13]; F.w_gate_up = args.in[14]; F.w_down = args.in[15]; F.gf = args.in[16];
    F.out = args.out;
    F.MODP = (float*)(ws + WS_MODP); F.MODF = (float*)(ws + WS_MODF); F.X1 = (float*)(ws + WS_X1);
    F.Win_t = (bf16*)(ws + WS_WIN); F.Wcp_t = (bf16*)(ws + WS_WCP); F.Wpg_t = (bf16*)(ws + WS_WPG); F.Wo_t = (bf16*)(ws + WS_WO); F.Wgu_t = (bf16*)(ws + WS_WGU); F.Wd_t = (bf16*)(ws + WS_WD);
    F.H = (bf16*)(ws + WS_H); F.PROJ = (bf16*)(ws + WS_PROJ); F.AM = (bf16*)(ws + WS_AM); F.POOLED = (bf16*)(ws + WS_POOLED); F.MERGED = (bf16*)(ws + WS_MERGED); F.H2 = (bf16*)(ws + WS_H2); F.ACT = (bf16*)(ws + WS_ACT);
    for (int u = F.tid; u < 32; u += NWAVES * 64) F.MISC[u] = 0u;
    __syncthreads();
    XcdBarrier bar; bar.bar = (unsigned*)(F.ctl + CW_BAR); bar.x = 0; bar.st = nullptr;
    if (N_LAUNCHES == 1) bar = xcd_barrier_post((unsigned*)(F.ctl + CW_BAR), F.MISC + 8);
#define GRID_BAR() do { if (N_LAUNCHES == 1) xcd_barrier(bar); } while (0)
    const int lo = args.ph_lo, hi = args.ph_hi;
#define IN(k) (lo <= (k) && (k) < hi)
#define REPS(k) (((PROBE_DUP >> (k)) & 1) ? 2 : 1)
#define BOTH(k) (IN(k) && IN((k) + 1))

    if (IN(0)) { for (int rep = 0; rep < REPS(0); ++rep) { p0_prologue(F); __syncthreads(); } if (BOTH(0)) GRID_BAR(); }
    if (IN(1)) { for (int rep = 0; rep < REPS(1); ++rep) { p1_norm1(F); __syncthreads(); } if (BOTH(1)) GRID_BAR(); }
    if (IN(2)) {
        pg8::Gemm g{D, D, D}; pg8::Order<0, WGM_P2> O; O.init(S, INC, F.G, (int)blockIdx.x, F.H, F.Win_t, D, D);
        pg8::EpiBf16 E{F.PROJ, INC, nullptr};
        if (PROBE_SUB) { if ((int)blockIdx.x < PROBE_SUB) { pg8::Order<0, 4> OS; OS.init(S, 14336, PROBE_SUB, (int)blockIdx.x, F.H, F.Win_t, D, D); pg8::gemm_phase<pg8::EpiBf16, pg8::Order<0, 4>>(F.lds + RING_OFF, g, OS, E); } __syncthreads(); }
        if (PROBE_ZERO) { pg8::Order<0, 4> OZ; OZ.init(S, INC, F.G, (int)blockIdx.x, ws + WS_END, ws + WS_END + 64 * MiB, D, D); pg8::gemm_phase<pg8::EpiBf16, pg8::Order<0, 4>>(F.lds + RING_OFF, g, OZ, E); }
        for (int rep = 0; rep < REPS(2); ++rep) pg8::gemm_phase<pg8::EpiBf16, pg8::Order<0, WGM_P2>>(F.lds + RING_OFF, g, O, E);
        if (BOTH(2)) GRID_BAR();
    }
    if (IN(3)) { for (int rep = 0; rep < REPS(3); ++rep) p3_conv_pool(F); if (BOTH(3)) GRID_BAR(); }
    if (IN(4)) {
        pg8::Gemm g{PGRP, PW, PGRP}; pg8::Order<1, WGM_P4> O; O.init(S, PW, F.G, (int)blockIdx.x, F.POOLED, F.Wpg_t, PW, PGRP);
        pg8::EpiBf16 E{F.AM + CW, D, F.pool_scale};
        for (int rep = 0; rep < REPS(4); ++rep) pg8::gemm_phase<pg8::EpiBf16, pg8::Order<1, WGM_P4>>(F.lds + RING_OFF, g, O, E);
        if (BOTH(4)) GRID_BAR();
    }
    if (IN(5)) {
        pg8::Gemm g{CW, D, D}; pg8::Order<2, WGM_P5> O; O.init(S, D, F.G, (int)blockIdx.x, F.AM, F.Wcp_t, D, D);
        pg8::EpiMerge E{F.PROJ, F.gbias, F.MERGED};
        for (int rep = 0; rep < REPS(5); ++rep) pg8::gemm_phase<pg8::EpiMerge, pg8::Order<2, WGM_P5>>(F.lds + RING_OFF, g, O, E);
        if (BOTH(5)) GRID_BAR();
    }
    if (IN(6)) {
        pg8::Gemm g{D, D, D}; pg8::Order<0, WGM_P6> O; O.init(S, D, F.G, (int)blockIdx.x, F.MERGED, F.Wo_t, D, D);
        pg8::EpiResid E{F.x, F.MODF + 2 * D, F.X1, D};
        for (int rep = 0; rep < REPS(6); ++rep) pg8::gemm_phase<pg8::EpiResid, pg8::Order<0, WGM_P6>>(F.lds + RING_OFF, g, O, E);
        if (BOTH(6)) GRID_BAR();
    }
    if (IN(7)) { for (int rep = 0; rep < REPS(7); ++rep) { p7_norm2(F); __syncthreads(); } if (BOTH(7)) GRID_BAR(); }
    if (IN(8)) {
        pg8::Gemm g{D, D, D}; pg8::Order<0, WGM_P8> O; O.init(S, 2 * FF, F.G, (int)blockIdx.x, F.H2, F.Wgu_t, D, D);
        pg8::EpiSwiglu E{F.ACT, FF};
        for (int rep = 0; rep < REPS(8); ++rep) pg8::gemm_phase<pg8::EpiSwiglu, pg8::Order<0, WGM_P8>>(F.lds + RING_OFF, g, O, E);
        p8_tail_convert_wd(F);
        if (BOTH(8)) GRID_BAR();
    }
    if (IN(9)) {
        pg8::Gemm g{FF, FF, FF}; pg8::Order<0, WGM_P9> O; O.init(S, D, F.G, (int)blockIdx.x, F.ACT, F.Wd_t, FF, FF);
        pg8::EpiResid E{F.X1, F.MODF + 5 * D, F.out, D};
        for (int rep = 0; rep < REPS(9); ++rep) pg8::gemm_phase<pg8::EpiResid, pg8::Order<0, WGM_P9>>(F.lds + RING_OFF, g, O, E);
        if (BOTH(9)) GRID_BAR();
    }
    if (IN(10)) { p10_final_norm(F); }
#undef IN
#undef BOTH
#undef GRID_BAR
}

extern "C" void kernel_launch(void* const* d_in, const int* in_sizes, int n_in, void* d_out, int out_size, void* d_ws, size_t ws_size, hipStream_t stream) {
    static int grid = 0;
    if (grid == 0) {
        if (n_in != 17 || in_sizes[0] != S * D || out_size != S * D || ws_size < WS_END) { fprintf(stderr, "kernel_launch: unexpected shapes (n_in %d, in0 %d, out %d, ws %zu); nothing launched\n", n_in, n_in > 0 ? in_sizes[0] : -1, out_size, ws_size); grid = -1; return; }
        int dev = 0, cus = 0, per_cu = 0;
        if (hipGetDevice(&dev) != hipSuccess || hipDeviceGetAttribute(&cus, hipDeviceAttributeMultiprocessorCount, dev) != hipSuccess) { fprintf(stderr, "kernel_launch: device query failed\n"); grid = -1; return; }
        if (hipFuncSetAttribute((const void*)mk_fwd, hipFuncAttributeMaxDynamicSharedMemorySize, LDS_BYTES) != hipSuccess) { fprintf(stderr, "kernel_launch: hipFuncSetAttribute failed\n"); grid = -1; return; }
        if (hipOccupancyMaxActiveBlocksPerMultiprocessor(&per_cu, (const void*)mk_fwd, NWAVES * 64, LDS_BYTES) != hipSuccess || per_cu < 1)
            fprintf(stderr, "kernel_launch: note: occupancy query reports %d workgroups per CU\n", per_cu);
        (void)hipGetLastError();
        grid = cus;
    }
    if (grid < 0) return;
    if (hipMemsetAsync((char*)d_ws + WS_CTL, 0, CTL_ZERO_BYTES, stream) != hipSuccess) { fprintf(stderr, "kernel_launch: hipMemsetAsync failed\n"); return; }
    if (PROBE_ZERO) (void)hipMemsetAsync((char*)d_ws + WS_END, 0, 192 * MiB, stream);
    Args a{};
    for (int i = 0; i < 17; ++i) a.in[i] = (const float*)d_in[i];
    a.out = (float*)d_out; a.ws = (unsigned char*)d_ws;
    if (N_LAUNCHES == 1) { a.ph_lo = 0; a.ph_hi = PER_PHASE; hipLaunchKernelGGL(mk_fwd, dim3(grid), dim3(NWAVES * 64), LDS_BYTES, stream, a); }
    else for (int p = 0; p < PER_PHASE; ++p) { a.ph_lo = p; a.ph_hi = p + 1; hipLaunchKernelGGL(mk_fwd, dim3(grid), dim3(NWAVES * 64), LDS_BYTES, stream, a); }
    const hipError_t le = hipPeekAtLastError();
    if (le != hipSuccess) fprintf(stderr, "kernel_launch: launch failed: %s\n", hipGetErrorName(le));
}
```

```cpp
#include <hip/hip_runtime.h>
#include <cstdio>
#include <cstdint>

#ifndef PROBE_DUP
#define PROBE_DUP 0
#endif
#ifndef PROBE_ZERO
#define PROBE_ZERO 0
#endif
#ifndef PROBE_SUB
#define PROBE_SUB 0
#endif
#ifndef MK_N_LAUNCHES
#define MK_N_LAUNCHES 1
#endif

namespace pg8 {
#define PG8_LAS __attribute__((address_space(3)))
typedef unsigned short bf16_t;
typedef short bf16x8 __attribute__((ext_vector_type(8)));
typedef float f32x4 __attribute__((ext_vector_type(4)));
typedef unsigned u32x4 __attribute__((ext_vector_type(4)));
constexpr int BM = 256, BK = 64, HALF = 128, HTB = HALF * BK * 2  , STAGE_BYTES = 8 * HTB, NXCD = 8;

__host__ __device__ __forceinline__ int lds_byte(int r, int c) { const int st = (r >> 4) * 2 + (c >> 5), rr = r & 15, cc = c & 31, ob = rr * 64 + cc * 2; return st * 1024 + (ob ^ (((ob >> 9) & 1) << 5)); }
__host__ __device__ __forceinline__ void stage_rc(int b, int& R, int& C) { const int st = b / 1024, sb = b % 1024, swz = sb ^ (((sb >> 9) & 1) << 5); R = (st >> 1) * 16 + swz / 64; C = (st & 1) * 32 + (swz % 64) / 2; }
__host__ __device__ __forceinline__ int perm32(int rho) { const int n = rho >> 4, i = rho & 15; return 8 * (i >> 2) + 4 * n + (i & 3); }

struct Unit { int pm, pn, half; const char* a; const char* b; };
struct Gemm { int K, lda, ldb; };

#ifndef CFG_STAGGER
#define CFG_STAGGER 0
#endif
template <int MODE, int WGM> struct Order {
    int nM, nN, nwg, G, c; const char* A; const char* B; size_t a_tile, b_tile;
    __device__ __forceinline__ void init(int M, int N, int G_, int c_, const void* A_, const void* B_, int lda, int ldb) { nM = M / BM; nN = N / BM; nwg = nM * nN; G = G_; c = c_; A = (const char*)A_; B = (const char*)B_; a_tile = (size_t)BM * lda * 2; b_tile = (size_t)BM * ldb * 2; }
    __device__ __forceinline__ bool next(int i, Unit& u) const {
        const int ti = (MODE == 2) ? (i >> 1) : i;
        const long L = (long)ti * G + c; if (L >= nwg || c >= G) return false;
        int wgid = (int)L; const int xcd = wgid % NXCD; { const int q = nwg / NXCD, r = nwg % NXCD, off = wgid / NXCD; wgid = (xcd < r ? xcd * (q + 1) : r * (q + 1) + (xcd - r) * q) + off; }
        const int nig = WGM * nN, gid = wgid / nig, fm = gid * WGM, gsz = (nM - fm) < WGM ? (nM - fm) : WGM;
        u.pm = fm + ((wgid % nig) % gsz); u.pn = (wgid % nig) / gsz; u.half = (MODE == 2) ? (i & 1) : 0;
        if (CFG_STAGGER) u.pn = (u.pn + xcd * (nN / NXCD)) % nN;
        u.a = A + (size_t)u.pm * a_tile + (MODE == 1 ? (size_t)(u.pn >> 1) * 1024 : 0) + (MODE == 2 ? (size_t)u.half * 4096 : 0);
        u.b = B + (size_t)u.pn * b_tile + (MODE == 2 ? (size_t)u.half * 4096 : 0);
        return true;
    }
};

__device__ __forceinline__ unsigned cvt_pk_bf16(float lo, float hi) { unsigned r; asm volatile("v_cvt_pk_bf16_f32 %0, %1, %2" : "=v"(r) : "v"(lo), "v"(hi)); return r; }
__device__ __forceinline__ float bf_lo(unsigned w) { return __uint_as_float(w << 16); }
__device__ __forceinline__ float bf_hi(unsigned w) { return __uint_as_float(w & 0xffff0000u); }
__device__ __forceinline__ float exp_neg(float x) { return __builtin_amdgcn_exp2f(x * -1.44269504089f); }

struct EpiBf16 {
    static constexpr bool PERM = true;
    bf16_t* O; int ldc; const float* scale;
    __device__ __forceinline__ bool keep(const Unit&) const { return false; }
    __device__ __forceinline__ void operator()(f32x4 (&acc)[2][2][4][2], const Unit& u, int wr, int wc, int fr, int fq) const {
        const int row0 = u.pm * BM + wr * 64 + fr, col0 = u.pn * BM + wc * 32 + 8 * fq;
        f32x4 sv[2][2];
#pragma unroll
        for (int bj = 0; bj < 2; ++bj)
#pragma unroll
            for (int n = 0; n < 2; ++n) sv[bj][n] = scale ? *(const f32x4*)(scale + col0 + bj * HALF + 4 * n) : (f32x4){1.f, 1.f, 1.f, 1.f};
#pragma unroll
        for (int ai = 0; ai < 2; ++ai)
#pragma unroll
            for (int m = 0; m < 4; ++m) { bf16_t* rowp = O + (size_t)(row0 + ai * HALF + m * 16) * ldc + col0;
#pragma unroll
                for (int bj = 0; bj < 2; ++bj) { const f32x4 v0 = acc[ai][bj][m][0] * sv[bj][0], v1 = acc[ai][bj][m][1] * sv[bj][1];
                    u32x4 w; w.x = cvt_pk_bf16(v0[0], v0[1]); w.y = cvt_pk_bf16(v0[2], v0[3]); w.z = cvt_pk_bf16(v1[0], v1[1]); w.w = cvt_pk_bf16(v1[2], v1[3]);
                    *(u32x4*)(rowp + bj * HALF) = w; } }
    }
};
struct EpiMerge {
    static constexpr bool PERM = true;
    const bf16_t* proj; const float* gbias; bf16_t* O;
    __device__ __forceinline__ bool keep(const Unit& u) const { return u.half == 0; }
    __device__ __forceinline__ void operator()(f32x4 (&acc)[2][2][4][2], const Unit& u, int wr, int wc, int fr, int fq) const {
        const int row0 = u.pm * BM + wr * 64 + fr, col0 = u.pn * BM + wc * 32 + 8 * fq;
#pragma unroll
        for (int bj = 0; bj < 2; ++bj) {
            const int col = col0 + bj * HALF;
            const f32x4 bp0 = *(const f32x4*)(gbias + 4096 + col), bp1 = *(const f32x4*)(gbias + 4096 + col + 4);
            if (u.half == 0) {
                const f32x4 bc0 = *(const f32x4*)(gbias + col), bc1 = *(const f32x4*)(gbias + col + 4);
#pragma unroll
                for (int ai = 0; ai < 2; ++ai)
#pragma unroll
                    for (int m = 0; m < 4; ++m) { const bf16_t* rp = proj + (size_t)(row0 + ai * HALF + m * 16) * 16384 + col;
                        const u32x4 gc = *(const u32x4*)(rp + 8192), gp = *(const u32x4*)(rp + 12288);
#pragma unroll
                        for (int e = 0; e < 4; ++e) {
                            const float a0 = fmaxf(bf_lo(gc[e]) + (e < 2 ? bc0[2 * e] : bc1[2 * e - 4]), -60.f), a1 = fmaxf(bf_hi(gc[e]) + (e < 2 ? bc0[2 * e + 1] : bc1[2 * e - 3]), -60.f);
                            const float b0 = fmaxf(bf_lo(gp[e]) + (e < 2 ? bp0[2 * e] : bp1[2 * e - 4]), -60.f), b1 = fmaxf(bf_hi(gp[e]) + (e < 2 ? bp0[2 * e + 1] : bp1[2 * e - 3]), -60.f);
                            const float r0 = (1.f + exp_neg(b0)) * __builtin_amdgcn_rcpf(1.f + exp_neg(a0)), r1 = (1.f + exp_neg(b1)) * __builtin_amdgcn_rcpf(1.f + exp_neg(a1));
                            if (e < 2) { acc[ai][bj][m][0][2 * e] *= r0; acc[ai][bj][m][0][2 * e + 1] *= r1; } else { acc[ai][bj][m][1][2 * e - 4] *= r0; acc[ai][bj][m][1][2 * e - 3] *= r1; } } }
            } else {
#pragma unroll
                for (int ai = 0; ai < 2; ++ai)
#pragma unroll
                    for (int m = 0; m < 4; ++m) { const size_t row = (size_t)(row0 + ai * HALF + m * 16);
                        const u32x4 gp = *(const u32x4*)(proj + row * 16384 + 12288 + col); float s[8];
#pragma unroll
                        for (int e = 0; e < 4; ++e) {
                            const float b0 = fmaxf(bf_lo(gp[e]) + (e < 2 ? bp0[2 * e] : bp1[2 * e - 4]), -60.f), b1 = fmaxf(bf_hi(gp[e]) + (e < 2 ? bp0[2 * e + 1] : bp1[2 * e - 3]), -60.f);
                            s[2 * e] = __builtin_amdgcn_rcpf(1.f + exp_neg(b0)); s[2 * e + 1] = __builtin_amdgcn_rcpf(1.f + exp_neg(b1)); }
                        const f32x4 v0 = acc[ai][bj][m][0], v1 = acc[ai][bj][m][1];
                        u32x4 w; w.x = cvt_pk_bf16(v0[0] * s[0], v0[1] * s[1]); w.y = cvt_pk_bf16(v0[2] * s[2], v0[3] * s[3]); w.z = cvt_pk_bf16(v1[0] * s[4], v1[1] * s[5]); w.w = cvt_pk_bf16(v1[2] * s[6], v1[3] * s[7]);
                        *(u32x4*)(O + row * 4096 + col) = w; }
            }
        }
    }
};
struct EpiResid {
    static constexpr bool PERM = false;
    const float* base; const float* gate; float* out; int ldc;
    __device__ __forceinline__ bool keep(const Unit&) const { return false; }
    __device__ __forceinline__ void operator()(f32x4 (&acc)[2][2][4][2], const Unit& u, int wr, int wc, int fr, int fq) const {
        const int row0 = u.pm * BM + wr * 64 + fr, col0 = u.pn * BM + wc * 32 + 4 * fq;
        f32x4 gv[2][2];
#pragma unroll
        for (int bj = 0; bj < 2; ++bj)
#pragma unroll
            for (int n = 0; n < 2; ++n) gv[bj][n] = *(const f32x4*)(gate + col0 + bj * HALF + n * 16);
#pragma unroll
        for (int ai = 0; ai < 2; ++ai)
#pragma unroll
            for (int m = 0; m < 4; ++m) { const size_t off = (size_t)(row0 + ai * HALF + m * 16) * ldc + col0;
#pragma unroll
                for (int bj = 0; bj < 2; ++bj)
#pragma unroll
                    for (int n = 0; n < 2; ++n) { const f32x4 bs = *(const f32x4*)(base + off + bj * HALF + n * 16); *(f32x4*)(out + off + bj * HALF + n * 16) = bs + gv[bj][n] * acc[ai][bj][m][n]; }
                if (m & 1) asm volatile("" ::: "memory"); }
    }
};
struct EpiSwiglu {
    static constexpr bool PERM = true;
    bf16_t* O; int ldc;
    __device__ __forceinline__ bool keep(const Unit&) const { return false; }
    __device__ __forceinline__ void operator()(f32x4 (&acc)[2][2][4][2], const Unit& u, int wr, int wc, int fr, int fq) const {
        const int row0 = u.pm * BM + wr * 64 + fr, col0 = u.pn * HALF + wc * 32 + 8 * fq;
#pragma unroll
        for (int ai = 0; ai < 2; ++ai)
#pragma unroll
            for (int m = 0; m < 4; ++m) { float o[8];
#pragma unroll
                for (int n = 0; n < 2; ++n)
#pragma unroll
                    for (int e = 0; e < 4; ++e) { const float g = acc[ai][0][m][n][e], up = acc[ai][1][m][n][e]; o[4 * n + e] = g * __builtin_amdgcn_rcpf(1.f + exp_neg(g)) * up; }
                u32x4 w; w.x = cvt_pk_bf16(o[0], o[1]); w.y = cvt_pk_bf16(o[2], o[3]); w.z = cvt_pk_bf16(o[4], o[5]); w.w = cvt_pk_bf16(o[6], o[7]);
                *(u32x4*)(O + (size_t)(row0 + ai * HALF + m * 16) * ldc + col0) = w; }
    }
};

#ifndef CFG_ALIGN
#define CFG_ALIGN true
#endif
#ifndef CFG_SP2
#define CFG_SP2 true
#endif
template <class Epi, class Sched, bool ALIGN_EPI = CFG_ALIGN, bool SP2 = CFG_SP2>
__device__ __forceinline__ void gemm_phase(PG8_LAS unsigned char* lds, const Gemm g, const Sched& S, const Epi& E) {
    const int tid = threadIdx.x, wid = __builtin_amdgcn_readfirstlane(tid >> 6), lane = tid & 63, wr = wid >> 2, wc = wid & 3, fr = lane & 15, fq = lane >> 4;
    const int K = g.K, nt = K / BK;
    unsigned voffA[2], voffB[2];
#pragma unroll
    for (int i = 0; i < 2; ++i) { int R, C; stage_rc(tid * 16 + i * 8192, R, C); const int Rb = Epi::PERM ? ((R & ~31) + perm32(R & 31)) : R;
        voffA[i] = (unsigned)(R * g.lda + C) * 2u; voffB[i] = (unsigned)(Rb * g.ldb + C) * 2u; }
    const size_t kstep = (size_t)(BK * 2);
    const size_t hstepA = (size_t)HALF * g.lda * 2, hstepB = (size_t)HALF * g.ldb * 2;
    const unsigned ldsw = (unsigned)wid * 1024u;
    const int aoff = lds_byte(wr * 64 + fr, fq * 8), boff = lds_byte(wc * 32 + fr, fq * 8);
#define PG8_SA(b, h) (((b) * 2 + (h)) * HTB)
#define PG8_SB(b, h) ((4 + (b) * 2 + (h)) * HTB)
#ifndef CFG_AUXA
#define CFG_AUXA 0
#endif
#ifndef CFG_AUXB
#define CFG_AUXB 0
#endif
#define PG8_STAGE(bufoff, gbase, voff) do { _Pragma("unroll") for (int _i = 0; _i < 2; ++_i) { \
        if ((bufoff) >= 4 * HTB) __builtin_amdgcn_global_load_lds((const unsigned*)((const char*)(gbase) + (voff)[_i]), (PG8_LAS unsigned*)(lds + (bufoff) + ldsw + _i * 8192), 16, 0, CFG_AUXB); \
        else __builtin_amdgcn_global_load_lds((const unsigned*)((const char*)(gbase) + (voff)[_i]), (PG8_LAS unsigned*)(lds + (bufoff) + ldsw + _i * 8192), 16, 0, CFG_AUXA); } } while (0)
#define PG8_LDA(dst, b, h) do { _Pragma("unroll") for (int m = 0; m < 4; ++m) _Pragma("unroll") for (int k = 0; k < 2; ++k) dst[m][k] = *(const PG8_LAS bf16x8*)(lds + PG8_SA(b, h) + aoff + m * 2048 + k * 1024); } while (0)
#define PG8_LDB(dst, b, h) do { _Pragma("unroll") for (int n = 0; n < 2; ++n) _Pragma("unroll") for (int k = 0; k < 2; ++k) dst[n][k] = *(const PG8_LAS bf16x8*)(lds + PG8_SB(b, h) + boff + n * 2048 + k * 1024); } while (0)
#define PG8_MMA(ai, bj, At, Bt) do { __builtin_amdgcn_s_setprio(1); _Pragma("unroll") for (int m = 0; m < 4; ++m) _Pragma("unroll") for (int n = 0; n < 2; ++n) _Pragma("unroll") for (int k = 0; k < 2; ++k) \
        acc[ai][bj][m][n] = __builtin_amdgcn_mfma_f32_16x16x32_bf16(Bt[n][k], At[m][k], acc[ai][bj][m][n], 0, 0, 0); __builtin_amdgcn_s_setprio(0); } while (0)
#ifndef CFG_MMA2
#define CFG_MMA2 0
#endif
#define PG8_MMA2(ai, At, B0, B1) do { __builtin_amdgcn_s_setprio(1); \
    if (CFG_MMA2 == 1) { _Pragma("unroll") for (int k = 0; k < 2; ++k) _Pragma("unroll") for (int m = 0; m < 4; ++m) { \
        acc[ai][0][m][0] = __builtin_amdgcn_mfma_f32_16x16x32_bf16(B0[0][k], At[m][k], acc[ai][0][m][0], 0, 0, 0); acc[ai][0][m][1] = __builtin_amdgcn_mfma_f32_16x16x32_bf16(B0[1][k], At[m][k], acc[ai][0][m][1], 0, 0, 0); \
        acc[ai][1][m][0] = __builtin_amdgcn_mfma_f32_16x16x32_bf16(B1[0][k], At[m][k], acc[ai][1][m][0], 0, 0, 0); acc[ai][1][m][1] = __builtin_amdgcn_mfma_f32_16x16x32_bf16(B1[1][k], At[m][k], acc[ai][1][m][1], 0, 0, 0); } } \
    else { _Pragma("unroll") for (int k = 0; k < 2; ++k) _Pragma("unroll") for (int n = 0; n < 2; ++n) { \
        _Pragma("unroll") for (int m = 0; m < 4; ++m) acc[ai][0][m][n] = __builtin_amdgcn_mfma_f32_16x16x32_bf16(B0[n][k], At[m][k], acc[ai][0][m][n], 0, 0, 0); \
        _Pragma("unroll") for (int m = 0; m < 4; ++m) acc[ai][1][m][n] = __builtin_amdgcn_mfma_f32_16x16x32_bf16(B1[n][k], At[m][k], acc[ai][1][m][n], 0, 0, 0); } } \
    __builtin_amdgcn_s_setprio(0); } while (0)
#define PG8_WAIT_V(n) asm volatile("s_waitcnt vmcnt(" #n ")" ::: "memory")
#define PG8_WAIT_L(n) asm volatile("s_waitcnt lgkmcnt(" #n ")" ::: "memory")
#define PG8_BAR __builtin_amdgcn_s_barrier()
#define PG8_SCHED __builtin_amdgcn_sched_barrier(0)
    Unit cur, nxt; int ui = 0;
    if (!S.next(0, cur)) return;
    f32x4 acc[2][2][4][2];
#pragma unroll
    for (int a = 0; a < 2; ++a)
#pragma unroll
        for (int b = 0; b < 2; ++b)
#pragma unroll
            for (int m = 0; m < 4; ++m)
#pragma unroll
                for (int n = 0; n < 2; ++n) acc[a][b][m][n] = (f32x4){0.f, 0.f, 0.f, 0.f};
    bf16x8 At[4][2], B0[2][2], B1[2][2];
    const char* cA = cur.a; const char* cB = cur.b;
    if constexpr (SP2) {
        PG8_STAGE(PG8_SB(0, 0), cB, voffB); PG8_STAGE(PG8_SB(0, 1), cB + hstepB, voffB); PG8_STAGE(PG8_SA(0, 0), cA, voffA); PG8_STAGE(PG8_SA(0, 1), cA + hstepA, voffA);
        if (wr == 1) PG8_BAR;
        PG8_WAIT_V(2); PG8_BAR;
        PG8_STAGE(PG8_SB(1, 0), cB + kstep, voffB); PG8_STAGE(PG8_SA(1, 0), cA + kstep, voffA); PG8_STAGE(PG8_SB(1, 1), cB + hstepB + kstep, voffB);
        PG8_WAIT_V(6); PG8_BAR;
    } else {
        PG8_STAGE(PG8_SB(0, 0), cB, voffB); PG8_STAGE(PG8_SA(0, 0), cA, voffA); PG8_STAGE(PG8_SB(0, 1), cB + hstepB, voffB); PG8_STAGE(PG8_SA(0, 1), cA + hstepA, voffA);
        if (wr == 1) PG8_BAR;
        PG8_WAIT_V(4); PG8_BAR;
        PG8_STAGE(PG8_SB(1, 0), cB + kstep, voffB); PG8_STAGE(PG8_SA(1, 0), cA + kstep, voffA); PG8_STAGE(PG8_SB(1, 1), cB + hstepB + kstep, voffB);
        PG8_WAIT_V(6); PG8_BAR;
    }
    for (;;) {
        const bool has_next = S.next(ui + 1, nxt);
        const char* nA = has_next ? nxt.a : cA; const char* nB = has_next ? nxt.b : cB;
        for (int t = 0; t < nt; t += 2) {
            const bool last = (t == nt - 2);
            const char* a1 = cA + (size_t)(t + 1) * kstep;
            const char* a2 = last ? nA : cA + (size_t)(t + 2) * kstep; const char* b2 = last ? nB : cB + (size_t)(t + 2) * kstep;
            const char* a3 = a2 + kstep; const char* b3 = b2 + kstep;
            if constexpr (SP2) {
            PG8_LDB(B0, 0, 0); PG8_LDB(B1, 0, 1); PG8_SCHED; PG8_LDA(At, 0, 0); PG8_STAGE(PG8_SA(1, 1), a1 + hstepA, voffA);
            PG8_WAIT_V(8); PG8_WAIT_L(0); PG8_BAR; if (CFG_MMA2) PG8_MMA2(0, At, B0, B1); else { PG8_MMA(0, 0, At, B0); PG8_MMA(0, 1, At, B1); } PG8_BAR; PG8_SCHED;
            PG8_LDA(At, 0, 1); PG8_STAGE(PG8_SB(0, 0), b2, voffB); PG8_STAGE(PG8_SB(0, 1), b2 + hstepB, voffB); PG8_STAGE(PG8_SA(0, 0), a2, voffA);
            PG8_WAIT_V(8); PG8_WAIT_L(0); PG8_BAR; if (CFG_MMA2) PG8_MMA2(1, At, B0, B1); else { PG8_MMA(1, 0, At, B0); PG8_MMA(1, 1, At, B1); } PG8_BAR; PG8_SCHED;
            PG8_LDB(B0, 1, 0); PG8_LDB(B1, 1, 1); PG8_SCHED; PG8_LDA(At, 1, 0); PG8_STAGE(PG8_SA(0, 1), a2 + hstepA, voffA);
            PG8_WAIT_V(8); PG8_WAIT_L(0); PG8_BAR; if (CFG_MMA2) PG8_MMA2(0, At, B0, B1); else { PG8_MMA(0, 0, At, B0); PG8_MMA(0, 1, At, B1); } PG8_BAR; PG8_SCHED;
            PG8_LDA(At, 1, 1); PG8_STAGE(PG8_SB(1, 0), b3, voffB); PG8_STAGE(PG8_SB(1, 1), b3 + hstepB, voffB); PG8_STAGE(PG8_SA(1, 0), a3, voffA);
            PG8_WAIT_V(8); PG8_WAIT_L(0); PG8_BAR; if (CFG_MMA2) PG8_MMA2(1, At, B0, B1); else { PG8_MMA(1, 0, At, B0); PG8_MMA(1, 1, At, B1); } PG8_BAR; PG8_SCHED;
            } else {
            PG8_LDB(B0, 0, 0); PG8_SCHED; PG8_LDA(At, 0, 0); PG8_STAGE(PG8_SA(1, 1), a1 + hstepA, voffA);
            PG8_WAIT_L(8); PG8_BAR; PG8_WAIT_L(0); PG8_MMA(0, 0, At, B0); PG8_BAR; PG8_SCHED;
            PG8_LDB(B1, 0, 1); PG8_STAGE(PG8_SB(0, 0), b2, voffB);
            PG8_BAR; PG8_WAIT_L(0); PG8_MMA(0, 1, At, B1); PG8_BAR;
            PG8_LDA(At, 0, 1); PG8_STAGE(PG8_SA(0, 0), a2, voffA);
            PG8_BAR; PG8_WAIT_L(0); PG8_MMA(1, 0, At, B0); PG8_BAR; PG8_SCHED;
            PG8_STAGE(PG8_SB(0, 1), b2 + hstepB, voffB);
            PG8_WAIT_V(6); PG8_BAR; PG8_MMA(1, 1, At, B1); PG8_BAR;
            PG8_LDB(B0, 1, 0); PG8_SCHED; PG8_LDA(At, 1, 0); PG8_STAGE(PG8_SA(0, 1), a2 + hstepA, voffA);
            PG8_WAIT_L(8); PG8_BAR; PG8_WAIT_L(0); PG8_MMA(0, 0, At, B0); PG8_BAR; PG8_SCHED;
            PG8_LDB(B1, 1, 1); PG8_STAGE(PG8_SB(1, 0), b3, voffB);
            PG8_BAR; PG8_WAIT_L(0); PG8_MMA(0, 1, At, B1); PG8_BAR;
            PG8_LDA(At, 1, 1); PG8_STAGE(PG8_SA(1, 0), a3, voffA);
            PG8_BAR; PG8_WAIT_L(0); PG8_MMA(1, 0, At, B0); PG8_BAR; PG8_SCHED;
            PG8_STAGE(PG8_SB(1, 1), b3 + hstepB, voffB);
            PG8_WAIT_V(6); PG8_BAR; PG8_MMA(1, 1, At, B1); PG8_BAR;
            }
        }
        if constexpr (ALIGN_EPI) { if (wr == 0) PG8_BAR; }
        E(acc, cur, wr, wc, fr, fq);
        if (!has_next) break;
        if (!E.keep(cur)) {
#pragma unroll
        for (int a = 0; a < 2; ++a)
#pragma unroll
            for (int b = 0; b < 2; ++b)
#pragma unroll
                for (int m = 0; m < 4; ++m)
#pragma unroll
                    for (int n = 0; n < 2; ++n) acc[a][b][m][n] = (f32x4){0.f, 0.f, 0.f, 0.f};
        }
        cur = nxt; cA = nA; cB = nB; ++ui;
        if constexpr (ALIGN_EPI) { if (wr == 1) PG8_BAR; }
    }
    PG8_WAIT_V(0);
    if constexpr (!ALIGN_EPI) { if (wr == 0) PG8_BAR; }
    PG8_BAR;
#undef PG8_SA
#undef PG8_SB
#undef PG8_STAGE
#undef PG8_LDA
#undef PG8_LDB
#undef PG8_MMA
#undef PG8_MMA2
#undef PG8_WAIT_V
#undef PG8_WAIT_L
#undef PG8_BAR
#undef PG8_SCHED
}
}

#ifndef NCONV
#define NCONV 0
#endif
constexpr int NWAVES = 8;
constexpr int N_LAUNCHES = MK_N_LAUNCHES;
constexpr int PER_PHASE = 11;

constexpr int S = 8192, D = 4096, CW = 2048, PW = 2048, PGRP = 512, FF = 11008, INC = 16384, NMODV = 6 * D;
constexpr float EPS = 1e-6f;
constexpr int KSPLIT = 8;

constexpr size_t MiB = 1u << 20;
constexpr size_t WS_CTL = 0, CTL_ZERO_BYTES = 64 * 1024;
constexpr size_t WS_MODP = 1 * MiB;
constexpr size_t WS_MODF = WS_MODP + (size_t)KSPLIT * NMODV * 4;
constexpr size_t WS_WIN = 2 * MiB;
constexpr size_t WS_WCP = 130 * MiB;
constexpr size_t WS_WPG = 162 * MiB;
constexpr size_t WS_WO = 164 * MiB;
constexpr size_t WS_WGU = 196 * MiB;
constexpr size_t WS_WD = 368 * MiB;
constexpr size_t WS_H = 454 * MiB;
constexpr size_t WS_PROJ = 518 * MiB;
constexpr size_t WS_AM = 774 * MiB;
constexpr size_t WS_POOLED = 838 * MiB;
constexpr size_t WS_MERGED = 870 * MiB;
constexpr size_t WS_X1 = 934 * MiB;
constexpr size_t WS_H2 = 1062 * MiB;
constexpr size_t WS_ACT = 1126 * MiB;
constexpr size_t WS_END = 1298 * MiB;
static_assert(WS_MODF + NMODV * 4 <= WS_WIN && WS_ACT + (size_t)S * FF * 2 <= WS_END, "d_ws map");
constexpr int CW_QWD = 64;
constexpr int CW_BAR = 1024;
constexpr int RING_OFF = 0, RING_BYTES = 131072;
constexpr int LDSCTL_OFF = RING_BYTES + 8192, MISC_OFF = LDSCTL_OFF;
constexpr int LDS_BYTES = 147456;

#define GAS __attribute__((address_space(1)))
#define LAS __attribute__((address_space(3)))
typedef unsigned short bf16;
typedef unsigned v4u __attribute__((ext_vector_type(4)));
typedef float f32x4 __attribute__((ext_vector_type(4)));
typedef GAS unsigned gu32;
#define RLX_AGENT __ATOMIC_RELAXED, __HIP_MEMORY_SCOPE_AGENT
#define LDS_WAIT() asm volatile("s_waitcnt lgkmcnt(0)" ::: "memory")
__device__ __forceinline__ unsigned pk2(float lo, float hi) { return pg8::cvt_pk_bf16(lo, hi); }
__device__ __forceinline__ void unpack8(const v4u w, float (&f)[8]) {
#pragma unroll
    for (int e = 0; e < 4; ++e) { f[2 * e] = pg8::bf_lo(w[e]); f[2 * e + 1] = pg8::bf_hi(w[e]); } }
__device__ __forceinline__ v4u pack8(const float (&f)[8]) { v4u w; w.x = pk2(f[0], f[1]); w.y = pk2(f[2], f[3]); w.z = pk2(f[4], f[5]); w.w = pk2(f[6], f[7]); return w; }

#define XB_TMO      128
#define XB_XCNT(j)  (256  + 64 * (j))
#define XB_XSUB(j)  (1280 + 64 * (j))
#define XB_XGEN(j)  (2304 + 64 * (j))
#define XB_TOP      3328
#define XB_TOPGEN   3392
#define XCD_BAR_WORDS 3456
#define XB_SPIN_CAP (1u << 18)
static_assert((CW_BAR + XCD_BAR_WORDS) * 4 <= (int)CTL_ZERO_BYTES, "barrier words inside the memset region");

__device__ __forceinline__ unsigned xb_ld(unsigned* p)              { return __hip_atomic_load(p, __ATOMIC_RELAXED, __HIP_MEMORY_SCOPE_AGENT); }
__device__ __forceinline__ unsigned xb_add(unsigned* p, unsigned v) { return __hip_atomic_fetch_add(p, v, __ATOMIC_RELAXED, __HIP_MEMORY_SCOPE_AGENT); }
__device__ __forceinline__ unsigned xb_xcc_id() { return (unsigned)__builtin_amdgcn_s_getreg((3 << 11) | 20) & 0xFu; }
#define XB_SPIN(cond, bar) do { unsigned _sp = 0; while (cond) { __builtin_amdgcn_s_sleep(1); \
    if ((++_sp & 255u) == 0u) { if (xb_ld(&(bar)[XB_TMO])) break; if (_sp > XB_SPIN_CAP) { atomicAdd(&(bar)[XB_TMO], 1u); break; } } } } while (0)

struct XcdBarrier {
    unsigned* bar; unsigned x;
    volatile LAS unsigned* st;
};
__device__ __forceinline__ XcdBarrier xcd_barrier_post(unsigned* bar, volatile LAS unsigned* st) {
    XcdBarrier b; b.bar = bar; b.x = xb_xcc_id(); b.st = st;
    if (threadIdx.x == 0) (void)xb_add(&bar[XB_XCNT(b.x)], 1u);
    return b;
}
__device__ __forceinline__ void xcd_barrier_complete(unsigned* bar, unsigned x, unsigned& nloc, unsigned& nx) {
    const unsigned G = gridDim.x * gridDim.y * gridDim.z;
    unsigned sum, cnt, mine, sp = 0u;
    for (;;) {
        sum = 0u; cnt = 0u; mine = 0u;
#pragma unroll
        for (unsigned j = 0; j < 16; ++j) { const unsigned c = xb_ld(&bar[XB_XCNT(j)]); sum += c; cnt += (c > 0u) ? 1u : 0u; mine = (j == x) ? c : mine; }
        if (sum == G) break;
        __builtin_amdgcn_s_sleep(1);
        if ((++sp & 255u) == 0u) { if (xb_ld(&bar[XB_TMO])) break; if (sp > XB_SPIN_CAP) { atomicAdd(&bar[XB_TMO], 1u); break; } }
    }
    nloc = mine > 0u ? mine : 1u; nx = cnt > 0u ? cnt : 1u;
}
__device__ __forceinline__ void xcd_barrier(const XcdBarrier& b) {
    asm volatile("s_waitcnt vmcnt(0)" ::: "memory");
    __syncthreads();
    if (threadIdx.x == 0) {
        unsigned* bar = b.bar;
        __builtin_amdgcn_s_waitcnt(0);
        unsigned nloc = b.st[0], nx = b.st[1];
        if (nloc == 0u) { xcd_barrier_complete(bar, b.x, nloc, nx); b.st[0] = nloc; b.st[1] = nx; }
        const unsigned old = xb_add(&bar[XB_XSUB(b.x)], 1u);
        const unsigned gen = old / nloc;
        if (old + 1u == (gen + 1u) * nloc) {
            __builtin_amdgcn_fence(__ATOMIC_RELEASE, "agent");
            asm volatile("s_waitcnt vmcnt(0)" ::: "memory");
            const unsigned og = xb_add(&bar[XB_TOP], 1u);
            const unsigned tg = og / nx;
            if (og + 1u == (tg + 1u) * nx) xb_add(&bar[XB_TOPGEN], 1u);
            else XB_SPIN(xb_ld(&bar[XB_TOPGEN]) == tg, bar);
            __builtin_amdgcn_fence(__ATOMIC_ACQUIRE, "agent");
            xb_add(&bar[XB_XGEN(b.x)], 1u);
            asm volatile("s_waitcnt vmcnt(0)" ::: "memory");
        } else {
            XB_SPIN(xb_ld(&bar[XB_XGEN(b.x)]) == gen, bar);
            __builtin_amdgcn_fence(__ATOMIC_ACQUIRE, "agent");
            asm volatile("s_waitcnt vmcnt(0)" ::: "memory");
        }
    }
    __syncthreads();
}

struct Frame {
    LAS unsigned char* lds;
    volatile LAS unsigned* MISC;
    gu32* ctl;
    int tid, lane, wave;
    int vcu, G;
    const float *x, *cvec, *w_ada, *b_ada, *g1, *w_in, *gbias, *conv_w, *w_conv_out, *w_pool_group, *pool_scale, *w_pool_out, *w_o, *g2, *w_gate_up, *w_down, *gf;
    float* out;
    float *MODP, *MODF, *X1;
    bf16 *Win_t, *Wcp_t, *Wpg_t, *Wo_t, *Wgu_t, *Wd_t, *H, *PROJ, *AM, *POOLED, *MERGED, *H2, *ACT;
};

__device__ __forceinline__ float wave_sum(float v) {
#pragma unroll
    for (int o = 1; o < 64; o <<= 1) v += __shfl_xor(v, o);
    return v;
}

struct TrJob { const float* W; bf16* dst; int N, dpitch, k0, n0; };
__device__ __forceinline__ void tr_load(const TrJob& j, int lane, f32x4 (&v)[16]) {
    const GAS f32x4* src = (const GAS f32x4*)(j.W + (size_t)(j.k0 + (lane >> 4)) * j.N + j.n0 + 4 * (lane & 15));
#pragma unroll
    for (int i = 0; i < 16; ++i) v[i] = __builtin_nontemporal_load(src + (size_t)i * j.N);
}
__device__ __forceinline__ void tr_emit(const f32x4 (&v)[16], const TrJob& j, LAS float* scr, int lane) {
#pragma unroll
    for (int i = 0; i < 16; ++i) { LAS float* p = scr + (4 * i + (lane >> 4)) * 65 + 4 * (lane & 15); p[0] = v[i].x; p[1] = v[i].y; p[2] = v[i].z; p[3] = v[i].w; }
    LDS_WAIT(); asm volatile("" ::: "memory");
    const int c = lane >> 3;
#pragma unroll
    for (int q = 0; q < 8; ++q) { const int n = (lane & 7) + 8 * q; const LAS float* s = scr + (8 * c) * 65 + n;
        v4u o; o.x = pk2(s[0 * 65], s[1 * 65]); o.y = pk2(s[2 * 65], s[3 * 65]); o.z = pk2(s[4 * 65], s[5 * 65]); o.w = pk2(s[6 * 65], s[7 * 65]);
        *(GAS v4u*)(j.dst + (size_t)n * j.dpitch + 8 * c) = o; }
    LDS_WAIT(); asm volatile("" ::: "memory");
}
constexpr int DI_CV = (CW / 64) * (D / 64), DI_PG = 4 * (PGRP / 64) * (PGRP / 64), DI_O = (D / 64) * (D / 64), DI_GU = (D / 64) * (2 * FF / 64), DI_DN = (FF / 64) * (D / 64);
constexpr int NDEF = 2 * DI_CV + DI_PG + DI_O + DI_GU;
#ifndef NSIDE_ITEMS
#define NSIDE_ITEMS 20000
#endif
constexpr int NSIDE = (NCONV > 0) ? (NSIDE_ITEMS < NDEF ? NSIDE_ITEMS : NDEF) : 0;
struct DeferredJobs { const float *w_conv_out, *w_pool_out, *w_pool_group, *w_o, *w_gate_up; bf16 *Wcp_t, *Wpg_t, *Wo_t, *Wgu_t; int base;
    __device__ __forceinline__ void operator()(int r, TrJob& j) const {
        r += base;
        if (r < DI_CV) { const int nb = D / 64, kb = r / nb, n0 = (r % nb) * 64; j = TrJob{w_conv_out, Wcp_t + (size_t)n0 * D + kb * 64, D, D, kb * 64, n0}; return; } r -= DI_CV;
        if (r < DI_CV) { const int nb = D / 64, kb = r / nb, n0 = (r % nb) * 64; j = TrJob{w_pool_out, Wcp_t + (size_t)n0 * D + CW + kb * 64, D, D, kb * 64, n0}; return; } r -= DI_CV;
        if (r < DI_PG) { const int g = r / 64, q = r % 64, kb = q / 8, n0 = (q % 8) * 64; j = TrJob{w_pool_group + (size_t)g * PGRP * PGRP, Wpg_t + (size_t)(g * PGRP + n0) * PGRP + kb * 64, PGRP, PGRP, kb * 64, n0}; return; } r -= DI_PG;
        if (r < DI_O) { const int nb = D / 64, kb = r / nb, n0 = (r % nb) * 64; j = TrJob{w_o, Wo_t + (size_t)n0 * D + kb * 64, D, D, kb * 64, n0}; return; } r -= DI_O;
        { const int nb = 2 * FF / 64, kb = r / nb, n0 = (r % nb) * 64; const int isup = n0 >= FF, nn = isup ? n0 - FF : n0, drow = (nn >> 7) * 256 + isup * 128 + (nn & 127);
          j = TrJob{w_gate_up, Wgu_t + (size_t)drow * D + kb * 64, 2 * FF, D, kb * 64, n0}; }
    }
};
struct DownJobs { const float* w_down; bf16* Wd_t;
    __device__ __forceinline__ void operator()(int r, TrJob& j) const { const int nb = D / 64, kb = r / nb, n0 = (r % nb) * 64; j = TrJob{w_down, Wd_t + (size_t)n0 * FF + kb * 64, D, FF, kb * 64, n0}; }
};
template <int DEPTH, class Jobs> __device__ __forceinline__ void tr_stream(const Jobs& J, int nitems, int w0, int nw, LAS float* scr, int lane) {
    if constexpr (DEPTH == 3) {
        f32x4 va[16], vb[16], vc[16]; TrJob ja, jb, jc;
        int ia = w0, ib = ia + nw, ic = ib + nw;
        if (ia < nitems) { J(ia, ja); tr_load(ja, lane, va); }
        if (ib < nitems) { J(ib, jb); tr_load(jb, lane, vb); }
        while (ia < nitems) {
            if (ic < nitems) { J(ic, jc); tr_load(jc, lane, vc); }
            tr_emit(va, ja, scr, lane); ia = ic + nw;
            if (ib >= nitems) break;
            if (ia < nitems) { J(ia, ja); tr_load(ja, lane, va); }
            tr_emit(vb, jb, scr, lane); ib = ia + nw;
            if (ic >= nitems) break;
            if (ib < nitems) { J(ib, jb); tr_load(jb, lane, vb); }
            tr_emit(vc, jc, scr, lane); ic = ib + nw;
        }
    } else {
        f32x4 va[16], vb[16]; TrJob ja, jb;
        int ia = w0;
        if (ia < nitems) { J(ia, ja); tr_load(ja, lane, va); }
        while (ia < nitems) {
            const int ib = ia + nw;
            if (ib < nitems) { J(ib, jb); tr_load(jb, lane, vb); }
            tr_emit(va, ja, scr, lane);
            if (ib >= nitems) break;
            ia = ib + nw;
            if (ia < nitems) { J(ia, ja); tr_load(ja, lane, va); }
            tr_emit(vb, jb, scr, lane);
        }
    }
}
constexpr int PI_IN = (D / 64) * (INC / 64);
struct PrologueJobs { const float* w_in; bf16* Win_t; DeferredJobs dj;
    __device__ __forceinline__ void operator()(int r, TrJob& j) const {
        if (r < PI_IN) { const int nb = INC / 64, kb = r / nb, n0 = (r % nb) * 64; j = TrJob{w_in, Win_t + (size_t)n0 * D + kb * 64, INC, D, kb * 64, n0}; return; }
        dj(r - PI_IN, j);
    }
};
__device__ __forceinline__ void p0_prologue(Frame& F) {
    {
        LAS float* cs = (LAS float*)(F.lds);
        LAS float* red = (LAS float*)(F.lds + 16384);
        for (int i = F.tid; i < D; i += NWAVES * 64) { const float c = F.cvec[i]; cs[i] = c / (1.f + __expf(-c)); }
        __syncthreads();
        for (int it = blockIdx.x; it < 96 * KSPLIT; it += F.G) {
            const int cch = it % 96, kr = it / 96, rbase = kr * 512 + F.wave * 64;
            const float* wp = F.w_ada + (size_t)rbase * NMODV + cch * 256 + F.lane * 4;
            f32x4 a = (f32x4){0.f, 0.f, 0.f, 0.f};
#pragma unroll 1
            for (int r0 = 0; r0 < 64; r0 += 16) { f32x4 v[16];
#pragma unroll
                for (int q = 0; q < 16; ++q) v[q] = __builtin_nontemporal_load((const GAS f32x4*)(wp + (size_t)(r0 + q) * NMODV));
#pragma unroll
                for (int q = 0; q < 16; ++q) a += v[q] * cs[rbase + r0 + q]; }
            *(LAS f32x4*)(red + F.wave * 256 + F.lane * 4) = a;
            __syncthreads();
            if (F.tid < 256) { float s = 0.f;
#pragma unroll
                for (int w = 0; w < 8; ++w) s += red[w * 256 + F.tid];
                F.MODP[(size_t)kr * NMODV + cch * 256 + F.tid] = s; }
            __syncthreads();
        }
    }
    {
        LAS float* scr = (LAS float*)(F.lds + RING_OFF + F.wave * 16640);
        PrologueJobs J{F.w_in, F.Win_t, DeferredJobs{F.w_conv_out, F.w_pool_out, F.w_pool_group, F.w_o, F.w_gate_up, F.Wcp_t, F.Wpg_t, F.Wo_t, F.Wgu_t, 0}};
        tr_stream<2>(J, PI_IN + NDEF - NSIDE, F.vcu * NWAVES + F.wave, F.G * NWAVES, scr, F.lane);
    }
}
__device__ __forceinline__ void p2_side_convert(Frame& F, int nconv) {
    const int first = F.G - nconv; if ((int)blockIdx.x < first) return;
    DeferredJobs J{F.w_conv_out, F.w_pool_out, F.w_pool_group, F.w_o, F.w_gate_up, F.Wcp_t, F.Wpg_t, F.Wo_t, F.Wgu_t, NDEF - NSIDE};
    tr_stream<2>(J, NSIDE, ((int)blockIdx.x - first) * NWAVES + F.wave, nconv * NWAVES, (LAS float*)(F.lds + RING_OFF + F.wave * 16640), F.lane);
}
__device__ __forceinline__ void p8_tail_convert_wd(Frame& F) {
    const int nunits = (S / 256) * (2 * FF / 256), rounds = (nunits + F.G - 1) / F.G, nshort = rounds * F.G - nunits;
    int w0, nw;
    if (nshort > 0) { if ((int)blockIdx.x < F.G - nshort) return; w0 = ((int)blockIdx.x - (F.G - nshort)) * NWAVES + F.wave; nw = nshort * NWAVES; }
    else { w0 = (int)blockIdx.x * NWAVES + F.wave; nw = F.G * NWAVES; }
    DownJobs J{F.w_down, F.Wd_t};
    tr_stream<3>(J, DI_DN, w0, nw, (LAS float*)(F.lds + RING_OFF + F.wave * 16640), F.lane);
}

__device__ __forceinline__ void norm_rows_bf16(Frame& F, const float* src, bf16* dst, const LAS float* Amul, const LAS float* Badd) {
    const int gw = F.vcu * NWAVES + F.wave, NGW = F.G * NWAVES;
    for (int r = gw; r < S; r += NGW) {
        const GAS f32x4* xr = (const GAS f32x4*)(src + (size_t)r * D) + F.lane;
        f32x4 v[16]; float s = 0.f;
#pragma unroll
        for (int j = 0; j < 16; ++j) { v[j] = __builtin_nontemporal_load(xr + 64 * j); s += (v[j].x * v[j].x + v[j].y * v[j].y) + (v[j].z * v[j].z + v[j].w * v[j].w); }
        const float rstd = 1.f / sqrtf(wave_sum(s) * (1.f / D) + EPS);
        GAS unsigned long long* o8 = (GAS unsigned long long*)(dst + (size_t)r * D) + F.lane;
#pragma unroll
        for (int j = 0; j < 16; ++j) { const f32x4 a = *(const LAS f32x4*)(Amul + 4 * F.lane + 256 * j), b = *(const LAS f32x4*)(Badd + 4 * F.lane + 256 * j);
            const f32x4 o = v[j] * rstd * a + b;
            o8[64 * j] = (unsigned long long)pk2(o.x, o.y) | ((unsigned long long)pk2(o.z, o.w) << 32); }
    }
}

__device__ __forceinline__ void p1_norm1(Frame& F) {
    LAS float* Amul = (LAS float*)(F.lds); LAS float* Badd = (LAS float*)(F.lds + 16384);
    for (int d = F.tid; d < D; d += NWAVES * 64) { float sh = F.b_ada[d], sc = F.b_ada[D + d];
#pragma unroll
        for (int p = 0; p < KSPLIT; ++p) { sh += F.MODP[(size_t)p * NMODV + d]; sc += F.MODP[(size_t)p * NMODV + D + d]; }
        Amul[d] = F.g1[d] * (1.f + sc); Badd[d] = sh; }
    { const int gt = blockIdx.x * (NWAVES * 64) + F.tid;
      for (int j = gt; j < NMODV; j += F.G * NWAVES * 64) { float s = F.b_ada[j];
#pragma unroll
          for (int p = 0; p < KSPLIT; ++p) s += F.MODP[(size_t)p * NMODV + j];
          F.MODF[j] = s; } }
    __syncthreads();
    norm_rows_bf16(F, F.x, F.H, Amul, Badd);
}
__device__ __forceinline__ void p7_norm2(Frame& F) {
    LAS float* Amul = (LAS float*)(F.lds); LAS float* Badd = (LAS float*)(F.lds + 16384);
    for (int d = F.tid; d < D; d += NWAVES * 64) { Amul[d] = F.g2[d] * (1.f + F.MODF[4 * D + d]); Badd[d] = F.MODF[3 * D + d]; }
    __syncthreads();
    norm_rows_bf16(F, F.X1, F.H2, Amul, Badd);
}
__device__ __forceinline__ void p10_final_norm(Frame& F) {
    const int gw = F.vcu * NWAVES + F.wave, NGW = F.G * NWAVES;
    for (int r = gw; r < S; r += NGW) {
        GAS f32x4* xr = (GAS f32x4*)(F.out + (size_t)r * D) + F.lane;
        f32x4 v[16]; float s = 0.f;
#pragma unroll
        for (int j = 0; j < 16; ++j) { v[j] = xr[64 * j]; s += (v[j].x * v[j].x + v[j].y * v[j].y) + (v[j].z * v[j].z + v[j].w * v[j].w); }
        const float rstd = 1.f / sqrtf(wave_sum(s) * (1.f / D) + EPS);
#pragma unroll
        for (int j = 0; j < 16; ++j) { const f32x4 g = *(const GAS f32x4*)(F.gf + 4 * F.lane + 256 * j); xr[64 * j] = v[j] * rstd * g; }
    }
}

__device__ __forceinline__ void p3_conv_pool(Frame& F) {
    const int gt = blockIdx.x * (NWAVES * 64) + F.tid;
    for (int item = gt; item < (S / 16) * (CW / 8); item += F.G * NWAVES * 64) {
        const int c = (item & 255) * 8, t0 = (item >> 8) * 16;
        {
            float w0[8], w1[8], w2[8];
#pragma unroll
            for (int h = 0; h < 2; ++h) { const f32x4 a = *(const GAS f32x4*)(F.conv_w + c + 4 * h), b = *(const GAS f32x4*)(F.conv_w + CW + c + 4 * h), d = *(const GAS f32x4*)(F.conv_w + 2 * CW + c + 4 * h);
#pragma unroll
                for (int e = 0; e < 4; ++e) { w0[4 * h + e] = a[e]; w1[4 * h + e] = b[e]; w2[4 * h + e] = d[e]; } }
            float u1[8], u2[8];
#pragma unroll
            for (int e = 0; e < 8; ++e) { u1[e] = 0.f; u2[e] = 0.f; }
            if (t0 >= 2) {
                float a[8], b[8];
                unpack8(__builtin_nontemporal_load((const GAS v4u*)(F.PROJ + (size_t)(t0 - 2) * INC + CW + c)), a); unpack8(__builtin_nontemporal_load((const GAS v4u*)(F.PROJ + (size_t)(t0 - 2) * INC + 2 * CW + c)), b);
#pragma unroll
                for (int e = 0; e < 8; ++e) u2[e] = a[e] * b[e];
                unpack8(__builtin_nontemporal_load((const GAS v4u*)(F.PROJ + (size_t)(t0 - 1) * INC + CW + c)), a); unpack8(__builtin_nontemporal_load((const GAS v4u*)(F.PROJ + (size_t)(t0 - 1) * INC + 2 * CW + c)), b);
#pragma unroll
                for (int e = 0; e < 8; ++e) u1[e] = a[e] * b[e];
            }
#pragma unroll 4
            for (int i = 0; i < 16; ++i) { const bf16* rp = F.PROJ + (size_t)(t0 + i) * INC + c;
                float gb[8], gc[8], vv[8], o[8];
                unpack8(__builtin_nontemporal_load((const GAS v4u*)(rp)), gb); unpack8(__builtin_nontemporal_load((const GAS v4u*)(rp + CW)), gc); unpack8(__builtin_nontemporal_load((const GAS v4u*)(rp + 2 * CW)), vv);
#pragma unroll
                for (int e = 0; e < 8; ++e) { const float u0 = gc[e] * vv[e]; o[e] = gb[e] * (w0[e] * u2[e] + w1[e] * u1[e] + w2[e] * u0); u2[e] = u1[e]; u1[e] = u0; }
                *(GAS v4u*)(F.AM + (size_t)(t0 + i) * D + c) = pack8(o); }
        }
        {
            const int W = 2 << (c >> 9);
            const bf16* pp = F.PROJ + 3 * CW + c;
            float sum[8];
#pragma unroll
            for (int e = 0; e < 8; ++e) sum[e] = 0.f;
            for (int j = (t0 - W + 1 > 0 ? t0 - W + 1 : 0); j < t0; ++j) { float a[8]; unpack8(__builtin_nontemporal_load((const GAS v4u*)(pp + (size_t)j * INC)), a);
#pragma unroll
                for (int e = 0; e < 8; ++e) sum[e] += a[e]; }
#pragma unroll 4
            for (int i = 0; i < 16; ++i) { const int t = t0 + i; float pn[8], po[8], o[8];
                unpack8(__builtin_nontemporal_load((const GAS v4u*)(pp + (size_t)t * INC)), pn);
                const int told = t - W + 1;
                if (told >= 0) unpack8(__builtin_nontemporal_load((const GAS v4u*)(pp + (size_t)told * INC)), po); else {
#pragma unroll
                    for (int e = 0; e < 8; ++e) po[e] = 0.f; }
                const float inv = 1.f / (float)(t + 1 < W ? t + 1 : W);
#pragma unroll
                for (int e = 0; e < 8; ++e) { sum[e] += pn[e]; o[e] = sum[e] * inv - pn[e]; sum[e] -= po[e]; }
                *(GAS v4u*)(F.POOLED + (size_t)t * PW + c) = pack8(o); }
        }
    }
}

#ifndef WGM_P2
#define WGM_P2 4
#endif
#ifndef WGM_P4
#define WGM_P4 4
#endif
#ifndef WGM_P5
#define WGM_P5 4
#endif
#ifndef WGM_P6
#define WGM_P6 4
#endif
#ifndef WGM_P8
#define WGM_P8 4
#endif
#ifndef WGM_P9
#define WGM_P9 4
#endif
struct Args { const float* in[17]; float* out; unsigned char* ws; int ph_lo, ph_hi; };
__global__ void __launch_bounds__(NWAVES * 64, 2) mk_fwd(Args args) {
    extern __shared__ __attribute__((aligned(16))) unsigned char lds[];
    Frame F;
    F.lds = (LAS unsigned char*)lds;
    F.MISC = (volatile LAS unsigned*)(F.lds + MISC_OFF);
    F.tid = threadIdx.x; F.lane = F.tid & 63; F.wave = __builtin_amdgcn_readfirstlane(F.tid >> 6);
    F.G = gridDim.x; { const int bx = blockIdx.x; F.vcu = (F.G % 8 == 0) ? (bx % 8) * (F.G / 8) + bx / 8 : bx; }
    unsigned char* ws = args.ws;
    F.ctl = (gu32*)(ws + WS_CTL);
    F.x = args.in[0]; F.cvec = args.in[1]; F.w_ada = args.in[2]; F.b_ada = args.in[3]; F.g1 = args.in[4]; F.w_in = args.in[5]; F.gbias = args.in[6]; F.conv_w = args.in[7];
    F.w_conv_out = args.in[8]; F.w_pool_group = args.in[9]; F.pool_scale = args.in[10]; F.w_pool_out = args.in[11]; F.w_o = args.in[12]; F.g2 = args.in[13]; F.w_gate_up = args.in[14]; F.w_down = args.in[15]; F.gf = args.in[16];
    F.out = args.out;
    F.MODP = (float*)(ws + WS_MODP); F.MODF = (float*)(ws + WS_MODF); F.X1 = (float*)(ws + WS_X1);
    F.Win_t = (bf16*)(ws + WS_WIN); F.Wcp_t = (bf16*)(ws + WS_WCP); F.Wpg_t = (bf16*)(ws + WS_WPG); F.Wo_t = (bf16*)(ws + WS_WO); F.Wgu_t = (bf16*)(ws + WS_WGU); F.Wd_t = (bf16*)(ws + WS_WD);
    F.H = (bf16*)(ws + WS_H); F.PROJ = (bf16*)(ws + WS_PROJ); F.AM = (bf16*)(ws + WS_AM); F.POOLED = (bf16*)(ws + WS_POOLED); F.MERGED = (bf16*)(ws + WS_MERGED); F.H2 = (bf16*)(ws + WS_H2); F.ACT = (bf16*)(ws + WS_ACT);
    for (int u = F.tid; u < 32; u += NWAVES * 64) F.MISC[u] = 0u;
    __syncthreads();
    XcdBarrier bar; bar.bar = (unsigned*)(F.ctl + CW_BAR); bar.x = 0; bar.st = nullptr;
    if (N_LAUNCHES == 1) bar = xcd_barrier_post((unsigned*)(F.ctl + CW_BAR), F.MISC + 8);
#define GRID_BAR() do { if (N_LAUNCHES == 1) xcd_barrier(bar); } while (0)
    const int lo = args.ph_lo, hi = args.ph_hi;
#define IN(k) (lo <= (k) && (k) < hi)
#define REPS(k) (((PROBE_DUP >> (k)) & 1) ? 2 : 1)
#define BOTH(k) (IN(k) && IN((k) + 1))

    if (IN(0)) { for (int rep = 0; rep < REPS(0); ++rep) { p0_prologue(F); __syncthreads(); } if (BOTH(0)) GRID_BAR(); }
    if (IN(1)) { for (int rep = 0; rep < REPS(1); ++rep) { p1_norm1(F); __syncthreads(); } if (BOTH(1)) GRID_BAR(); }
    if (IN(2)) {
        pg8::Gemm g{D, D, D}; pg8::Order<0, WGM_P2> O; O.init(S, INC, F.G - NCONV, (int)blockIdx.x, F.H, F.Win_t, D, D);
        pg8::EpiBf16 E{F.PROJ, INC, nullptr};
        if (PROBE_SUB) { if ((int)blockIdx.x < PROBE_SUB) { pg8::Order<0, 4> OS; OS.init(S, 14336, PROBE_SUB, (int)blockIdx.x, F.H, F.Win_t, D, D); pg8::gemm_phase<pg8::EpiBf16, pg8::Order<0, 4>>(F.lds + RING_OFF, g, OS, E); } __syncthreads(); GRID_BAR(); }
        if (PROBE_ZERO) { pg8::Order<0, 4> OZ; OZ.init(S, INC, F.G, (int)blockIdx.x, ws + WS_END, ws + WS_END + 64 * MiB, D, D); pg8::gemm_phase<pg8::EpiBf16, pg8::Order<0, 4>>(F.lds + RING_OFF, g, OZ, E); }
        for (int rep = 0; rep < REPS(2); ++rep) pg8::gemm_phase<pg8::EpiBf16, pg8::Order<0, WGM_P2>>(F.lds + RING_OFF, g, O, E);
        if (NCONV > 0) p2_side_convert(F, NCONV);
        if (BOTH(2)) GRID_BAR();
    }
    if (IN(3)) { for (int rep = 0; rep < REPS(3); ++rep) p3_conv_pool(F); if (BOTH(3)) GRID_BAR(); }
    if (IN(4)) {
        pg8::Gemm g{PGRP, PW, PGRP}; pg8::Order<1, WGM_P4> O; O.init(S, PW, F.G, (int)blockIdx.x, F.POOLED, F.Wpg_t, PW, PGRP);
        pg8::EpiBf16 E{F.AM + CW, D, F.pool_scale};
        for (int rep = 0; rep < REPS(4); ++rep) pg8::gemm_phase<pg8::EpiBf16, pg8::Order<1, WGM_P4>>(F.lds + RING_OFF, g, O, E);
        if (BOTH(4)) GRID_BAR();
    }
    if (IN(5)) {
        pg8::Gemm g{CW, D, D}; pg8::Order<2, WGM_P5> O; O.init(S, D, F.G, (int)blockIdx.x, F.AM, F.Wcp_t, D, D);
        pg8::EpiMerge E{F.PROJ, F.gbias, F.MERGED};
        for (int rep = 0; rep < REPS(5); ++rep) pg8::gemm_phase<pg8::EpiMerge, pg8::Order<2, WGM_P5>>(F.lds + RING_OFF, g, O, E);
        if (BOTH(5)) GRID_BAR();
    }
    if (IN(6)) {
        pg8::Gemm g{D, D, D}; pg8::Order<0, WGM_P6> O; O.init(S, D, F.G, (int)blockIdx.x, F.MERGED, F.Wo_t, D, D);
        pg8::EpiResid E{F.x, F.MODF + 2 * D, F.X1, D};
        for (int rep = 0; rep < REPS(6); ++rep) pg8::gemm_phase<pg8::EpiResid, pg8::Order<0, WGM_P6>>(F.lds + RING_OFF, g, O, E);
        if (BOTH(6)) GRID_BAR();
    }
    if (IN(7)) { for (int rep = 0; rep < REPS(7); ++rep) { p7_norm2(F); __syncthreads(); } if (BOTH(7)) GRID_BAR(); }
    if (IN(8)) {
        pg8::Gemm g{D, D, D}; pg8::Order<0, WGM_P8> O; O.init(S, 2 * FF, F.G, (int)blockIdx.x, F.H2, F.Wgu_t, D, D);
        pg8::EpiSwiglu E{F.ACT, FF};
        for (int rep = 0; rep < REPS(8); ++rep) pg8::gemm_phase<pg8::EpiSwiglu, pg8::Order<0, WGM_P8>>(F.lds + RING_OFF, g, O, E);
        p8_tail_convert_wd(F);
        if (BOTH(8)) GRID_BAR();
    }
    if (IN(9)) {
        pg8::Gemm g{FF, FF, FF}; pg8::Order<0, WGM_P9> O; O.init(S, D, F.G, (int)blockIdx.x, F.ACT, F.Wd_t, FF, FF);
        pg8::EpiResid E{F.X1, F.MODF + 5 * D, F.out, D};
        for (int rep = 0; rep < REPS(9); ++rep) pg8::gemm_phase<pg8::EpiResid, pg8::Order<0, WGM_P9>>(F.lds + RING_OFF, g, O, E);
        if (BOTH(9)) GRID_BAR();
    }
    if (IN(10)) { p10_final_norm(F); }
#undef IN
#undef BOTH
#undef GRID_BAR
}

extern "C" void kernel_launch(void* const* d_in, const int* in_sizes, int n_in, void* d_out, int out_size, void* d_ws, size_t ws_size, hipStream_t stream) {
    static int grid = 0;
    if (grid == 0) {
        if (n_in != 17 || in_sizes[0] != S * D || out_size != S * D || ws_size < WS_END) { fprintf(stderr, "kernel_launch: unexpected shapes (n_in %d, in0 %d, out %d, ws %zu); nothing launched\n", n_in, n_in > 0 ? in_sizes[0] : -1, out_size, ws_size); grid = -1; return; }
        int dev = 0, cus = 0, per_cu = 0;
        if (hipGetDevice(&dev) != hipSuccess || hipDeviceGetAttribute(&cus, hipDeviceAttributeMultiprocessorCount, dev) != hipSuccess) { fprintf(stderr, "kernel_launch: device query failed\n"); grid = -1; return; }
        if (hipFuncSetAttribute((const void*)mk_fwd, hipFuncAttributeMaxDynamicSharedMemorySize, LDS_BYTES) != hipSuccess) { fprintf(stderr, "kernel_launch: hipFuncSetAttribute failed\n"); grid = -1; return; }
        if (hipOccupancyMaxActiveBlocksPerMultiprocessor(&per_cu, (const void*)mk_fwd, NWAVES * 64, LDS_BYTES) != hipSuccess || per_cu < 1)
            fprintf(stderr, "kernel_launch: note: occupancy query reports %d workgroups per CU\n", per_cu);
        (void)hipGetLastError();
        grid = cus;
    }
    if (grid < 0) return;
    if (hipMemsetAsync((char*)d_ws + WS_CTL, 0, CTL_ZERO_BYTES, stream) != hipSuccess) { fprintf(stderr, "kernel_launch: hipMemsetAsync failed\n"); return; }
    if (PROBE_ZERO) (void)hipMemsetAsync((char*)d_ws + WS_END, 0, 192 * MiB, stream);
    Args a{};
    for (int i = 0; i < 17; ++i) a.in[i] = (const float*)d_in[i];
    a.out = (float*)d_out; a.ws = (unsigned char*)d_ws;
    if (N_LAUNCHES == 1) { a.ph_lo = 0; a.ph_hi = PER_PHASE; hipLaunchKernelGGL(mk_fwd, dim3(grid), dim3(NWAVES * 64), LDS_BYTES, stream, a); }
    else for (int p = 0; p < PER_PHASE; ++p) { a.ph_lo = p; a.ph_hi = p + 1; hipLaunchKernelGGL(mk_fwd, dim3(grid), dim3(NWAVES * 64), LDS_BYTES, stream, a); }
    const hipError_t le = hipPeekAtLastError();
    if (le != hipSuccess) fprintf(stderr, "kernel_launch: launch failed: %s\n", hipGetErrorName(le));
}
```
